# Optimizing an MI355X kernel written in HIP

```python
import math
import jax, jax.numpy as jnp
from jax import lax
import numpy as np

D_MODEL = 1024
BATCH = 4
SEQ = 8192
DEPTH = 4

GRID_W = 64
CTX_LEN = 256
BLOCK_Q = 128
CHUNK = 128
ROPE_BASE = 10000.0
EPS = 1e-6

A_HEADS = 6
A_KV_HEADS = 2
A_GROUP = A_HEADS // A_KV_HEADS
A_HEAD_DIM = 64
A_WIDTH = A_HEADS * A_HEAD_DIM
B_GROUPS = 4
B_GROUP_DIM = 64
B_WIDTH = B_GROUPS * B_GROUP_DIM
C_HEADS = 4
C_QK_DIM = 48
C_V_DIM = 2 * C_QK_DIM
C_WIDTH = C_HEADS * C_V_DIM
MIX_WIDTH = A_WIDTH + B_WIDTH + C_WIDTH
IN_SIZES = (A_WIDTH, A_KV_HEADS * A_HEAD_DIM, A_KV_HEADS * A_HEAD_DIM,
            B_WIDTH, B_WIDTH,
            2 * C_HEADS * C_QK_DIM, 2 * C_HEADS * C_QK_DIM, C_WIDTH)
IN_WIDTH = 2304
D_FF = 2816
N_MOD = 9

kernel_name = "hymba_style_gqa_gmlp_diffattn_macaron_dit"


def rms_norm(x, gain):
    xf = x.astype(jnp.float32)
    y = xf * lax.rsqrt(jnp.mean(xf * xf, axis=-1, keepdims=True) + EPS)
    return (y * gain.astype(jnp.float32)).astype(x.dtype)


def modulate(x, gain, shift, scale):
    return rms_norm(x, gain) * (1 + scale) + shift


def swiglu(h, w_in, w_out):
    gate, up = jnp.split(h @ w_in, 2, axis=-1)
    return (jax.nn.silu(gate) * up) @ w_out


def axial_angles(n, dim):
    rows = n // GRID_W
    row = jnp.repeat(jnp.arange(rows, dtype=jnp.float32), GRID_W)
    col = jnp.tile(jnp.arange(GRID_W, dtype=jnp.float32), rows)
    half = dim // 2
    freqs = 1.0 / (ROPE_BASE ** (jnp.arange(0, half, 2, dtype=jnp.float32) / half))
    return row[:, None] * freqs, col[:, None] * freqs


def rope_rotate(x, ang):
    m = ang.shape[-1]
    shape = (1, ang.shape[0]) + (1,) * (x.ndim - 3) + (m,)
    cos = jnp.cos(ang).reshape(shape).astype(x.dtype)
    sin = jnp.sin(ang).reshape(shape).astype(x.dtype)
    x1, x2 = x[..., :m], x[..., m:]
    return jnp.concatenate([x1 * cos - x2 * sin, x2 * cos + x1 * sin], axis=-1)


def axial_rope(x, ang_row, ang_col):
    half = x.shape[-1] // 2
    return jnp.concatenate([rope_rotate(x[..., :half], ang_row),
                            rope_rotate(x[..., half:], ang_col)], axis=-1)


def sweep_query_blocks(fn, q):
    b, n = q.shape[:2]
    qb = jnp.moveaxis(q.reshape((b, n // BLOCK_Q, BLOCK_Q) + q.shape[2:]), 1, 0)
    ob = jnp.moveaxis(lax.map(fn, qb), 0, 1)
    return ob.reshape((b, n) + ob.shape[3:])


def gqa_attend(q, k, v):
    s = jnp.einsum("bqhgd,bkhd->bhgqk", q, k).astype(jnp.float32) * (A_HEAD_DIM ** -0.5)
    p = jax.nn.softmax(s, axis=-1).astype(v.dtype)
    return jnp.einsum("bhgqk,bkhd->bqhgd", p, v)


def diff_attend(q, k, v, lam):
    s = jnp.einsum("bqchd,bkchd->bchqk", q, k).astype(jnp.float32) * (C_QK_DIM ** -0.5)
    p = jax.nn.softmax(s, axis=-1)
    a = (p[:, 0] - lam * p[:, 1]).astype(v.dtype)
    return jnp.einsum("bhqk,bkhe->bqhe", a, v)


def chunk_spatial_gate(u, v, w_s, b_s):
    b, n, _ = v.shape
    vc = v.reshape(b, n // CHUNK, CHUNK, B_GROUPS, B_GROUP_DIM)
    mixed = jnp.einsum("gpq,bnqgc->bnpgc", w_s, vc) + b_s.T[:, :, None]
    return u * mixed.reshape(b, n, B_WIDTH)


def split_heads(p):
    lead = p.shape[:2]
    idx = [int(i) for i in np.cumsum(IN_SIZES)[:-1]]
    qa, ka, va, u, v, qc, kc, vc = jnp.split(p, idx, axis=-1)
    return (qa.reshape(lead + (A_HEADS, A_HEAD_DIM)),
            ka.reshape(lead + (A_KV_HEADS, A_HEAD_DIM)),
            va.reshape(lead + (A_KV_HEADS, A_HEAD_DIM)),
            u, v,
            qc.reshape(lead + (2, C_HEADS, C_QK_DIM)),
            kc.reshape(lead + (2, C_HEADS, C_QK_DIM)),
            vc.reshape(lead + (C_HEADS, C_V_DIM)))


def token_mixing(hx, hc, w_in, w_out, g_q, g_k, g_v, w_s, b_s, lam_vecs, g_sub,
                 layer, ang_a, ang_c, with_ctx_out):
    b, n, _ = hx.shape
    L = hc.shape[1]
    qa_x, ka_x, va_x, u_x, v_x, qc_x, kc_x, vc_x = split_heads(hx @ w_in)
    qa_c, ka_c, va_c, u_c, v_c, qc_c, kc_c, vc_c = split_heads(hc @ w_in)

    qa_x = axial_rope(rms_norm(qa_x, g_q), *ang_a)
    ka_x = axial_rope(rms_norm(ka_x, g_k), *ang_a)
    qa_c = rms_norm(qa_c, g_q)
    ka_c = rms_norm(ka_c, g_k)
    ka_all = jnp.concatenate([ka_x, ka_c], axis=1)
    va_all = jnp.concatenate([va_x, va_c], axis=1)
    ya_x = sweep_query_blocks(lambda qb: gqa_attend(qb, ka_all, va_all),
                              qa_x.reshape(b, n, A_KV_HEADS, A_GROUP, A_HEAD_DIM)).reshape(b, n, A_WIDTH)

    yb_x = chunk_spatial_gate(jax.nn.gelu(u_x), rms_norm(jax.nn.gelu(v_x), g_v), w_s, b_s)

    lambda_init = 0.8 - 0.6 * math.exp(-0.3 * layer)
    lv = lam_vecs.astype(jnp.float32)
    lam = jnp.exp(jnp.sum(lv[0] * lv[1])) - jnp.exp(jnp.sum(lv[2] * lv[3])) + lambda_init
    qc_x = axial_rope(qc_x, *ang_c)
    kc_x = axial_rope(kc_x, *ang_c)
    kc_all = jnp.concatenate([kc_x, kc_c], axis=1)
    vc_all = jnp.concatenate([vc_x, vc_c], axis=1)
    yc_x = sweep_query_blocks(lambda qb: diff_attend(qb, kc_all, vc_all, lam), qc_x)
    yc_x = (rms_norm(yc_x, g_sub) * (1.0 - lambda_init)).reshape(b, n, C_WIDTH)

    out_x = jnp.concatenate([ya_x, yb_x, yc_x], axis=-1) @ w_out
    if not with_ctx_out:
        return out_x, None

    ya_c = gqa_attend(qa_c.reshape(b, L, A_KV_HEADS, A_GROUP, A_HEAD_DIM), ka_c, va_c).reshape(b, L, A_WIDTH)
    yb_c = chunk_spatial_gate(jax.nn.gelu(u_c), rms_norm(jax.nn.gelu(v_c), g_v), w_s, b_s)
    yc_c = (rms_norm(diff_attend(qc_c, kc_c, vc_c, lam), g_sub) * (1.0 - lambda_init)).reshape(b, L, C_WIDTH)
    out_c = jnp.concatenate([ya_c, yb_c, yc_c], axis=-1) @ w_out
    return out_x, out_c


def setup_inputs(seed: int = 0) -> dict:
    key = jax.random.key(seed)
    ks = jax.random.split(key, 24)
    f32 = jnp.float32
    nrm = lambda k, shape, s: jax.random.normal(k, shape, f32) * s
    gain = lambda k, shape: 1.0 + 0.05 * jax.random.normal(k, shape, f32)
    return {
        "x": nrm(ks[0], (BATCH, SEQ, D_MODEL), 1.0),
        "c": nrm(ks[1], (BATCH, D_MODEL), 1.0),
        "ctx": nrm(ks[2], (BATCH, CTX_LEN, D_MODEL), 1.0),
        "c_ctx": nrm(ks[3], (D_MODEL,), 1.0),
        "w_mod": nrm(ks[4], (DEPTH, D_MODEL, N_MOD * D_MODEL), 0.5 * D_MODEL ** -0.5),
        "b_mod": nrm(ks[5], (DEPTH, N_MOD * D_MODEL), 0.02),
        "g_ffn1": gain(ks[6], (DEPTH, D_MODEL)),
        "w_ffn1_in": nrm(ks[7], (DEPTH, D_MODEL, 2 * D_FF), D_MODEL ** -0.5),
        "w_ffn1_out": nrm(ks[8], (DEPTH, D_FF, D_MODEL), D_FF ** -0.5),
        "g_mix": gain(ks[9], (DEPTH, D_MODEL)),
        "w_mix_in": nrm(ks[10], (DEPTH, D_MODEL, IN_WIDTH), D_MODEL ** -0.5),
        "w_mix_out": nrm(ks[11], (DEPTH, MIX_WIDTH, D_MODEL), MIX_WIDTH ** -0.5),
        "g_qnorm": gain(ks[12], (DEPTH, A_HEAD_DIM)),
        "g_knorm": gain(ks[13], (DEPTH, A_HEAD_DIM)),
        "g_vnorm": gain(ks[14], (DEPTH, B_WIDTH)),
        "w_spatial": nrm(ks[15], (DEPTH, B_GROUPS, CHUNK, CHUNK), CHUNK ** -0.5),
        "b_spatial": gain(ks[16], (DEPTH, B_GROUPS, CHUNK)),
        "lambda_vecs": nrm(ks[17], (DEPTH, 4, C_QK_DIM), 0.1),
        "g_subln": gain(ks[18], (DEPTH, C_V_DIM)),
        "g_ffn2": gain(ks[19], (DEPTH, D_MODEL)),
        "w_ffn2_in": nrm(ks[20], (DEPTH, D_MODEL, 2 * D_FF), D_MODEL ** -0.5),
        "w_ffn2_out": nrm(ks[21], (DEPTH, D_FF, D_MODEL), D_FF ** -0.5),
        "g_final": gain(ks[22], (D_MODEL,)),
    }


def reference(x, c, ctx, c_ctx, w_mod, b_mod, g_ffn1, w_ffn1_in, w_ffn1_out, g_mix, w_mix_in,
              w_mix_out, g_qnorm, g_knorm, g_vnorm, w_spatial, b_spatial, lambda_vecs, g_subln,
              g_ffn2, w_ffn2_in, w_ffn2_out, g_final):
    n = x.shape[1]
    ang_a = axial_angles(n, A_HEAD_DIM)
    ang_c = axial_angles(n, C_QK_DIM)
    sc = jax.nn.silu(c)
    scc = jax.nn.silu(c_ctx)
    for l in range(DEPTH):
        last = l == DEPTH - 1
        mx = jnp.split((sc @ w_mod[l] + b_mod[l])[:, None, :], N_MOD, axis=-1)
        mc = jnp.split(scc @ w_mod[l] + b_mod[l], N_MOD, axis=-1)
        x = x + 0.5 * mx[2] * swiglu(modulate(x, g_ffn1[l], mx[0], mx[1]), w_ffn1_in[l], w_ffn1_out[l])
        ctx = ctx + 0.5 * mc[2] * swiglu(modulate(ctx, g_ffn1[l], mc[0], mc[1]), w_ffn1_in[l], w_ffn1_out[l])
        yx, yc = token_mixing(modulate(x, g_mix[l], mx[3], mx[4]), modulate(ctx, g_mix[l], mc[3], mc[4]),
                              w_mix_in[l], w_mix_out[l], g_qnorm[l], g_knorm[l], g_vnorm[l],
                              w_spatial[l], b_spatial[l], lambda_vecs[l], g_subln[l],
                              l, ang_a, ang_c, not last)
        x = x + mx[5] * yx
        x = x + 0.5 * mx[8] * swiglu(modulate(x, g_ffn2[l], mx[6], mx[7]), w_ffn2_in[l], w_ffn2_out[l])
        if not last:
            ctx = ctx + mc[5] * yc
            ctx = ctx + 0.5 * mc[8] * swiglu(modulate(ctx, g_ffn2[l], mc[6], mc[7]), w_ffn2_in[l], w_ffn2_out[l])
    return rms_norm(x, g_final)
```

```cpp
#include <hip/hip_runtime.h>
#include <hip/hip_cooperative_groups.h>
#include <cstdio>
#include <cstdint>
namespace cg = cooperative_groups;

#define LAS __attribute__((address_space(3)))
typedef unsigned short bf16_t;
typedef short bf16x8 __attribute__((ext_vector_type(8)));
typedef float f32x4 __attribute__((ext_vector_type(4)));
typedef float f32x2 __attribute__((ext_vector_type(2)));
typedef float f32x16 __attribute__((ext_vector_type(16)));
typedef unsigned u32x4 __attribute__((ext_vector_type(4)));
typedef unsigned u32x2 __attribute__((ext_vector_type(2)));

constexpr int DM = 1024, NB = 4, SEQ = 8192, DEPTH = 4, CTXL = 256, FF = 2816, NMOD = 9;
constexpr int RL = NB * SEQ;
constexpr int RC = NB * CTXL;
constexpr int R = RL + RC;
constexpr int INW = 2304;
constexpr float EPS = 1e-6f;
constexpr float LOG2E = 1.4426950408889634f;
constexpr int NTHREADS = 512, NWAVES = 8;

constexpr size_t MiB = 1u << 20;
constexpr size_t WS_CTL = 0;
constexpr size_t WS_MODV = 1 * MiB;
constexpr size_t WS_GTAB = WS_MODV + 768 * 1024;
constexpr size_t WS_W = 2 * MiB;
constexpr size_t W_1IN = 0;
constexpr size_t W_1OUT = W_1IN + (size_t)5632 * 1024 * 2;
constexpr size_t W_MIX = W_1OUT + (size_t)1024 * 2816 * 2;
constexpr size_t W_OUT = W_MIX + (size_t)2304 * 1024 * 2;
constexpr size_t W_2IN = W_OUT + (size_t)1024 * 1024 * 2;
constexpr size_t W_2OUT = W_2IN + (size_t)5632 * 1024 * 2;
constexpr size_t LAYER_W_BYTES = W_2OUT + (size_t)1024 * 2816 * 2;
constexpr size_t WS_XRES = WS_W + DEPTH * LAYER_W_BYTES;
constexpr size_t WS_H = WS_XRES + (size_t)R * DM * 4;
constexpr size_t WS_ACT = WS_H + (size_t)R * DM * 2;
constexpr size_t WS_PART = WS_ACT + (size_t)R * FF * 2;
constexpr size_t WS_END = WS_PART + (size_t)11 * RC * DM * 4;
constexpr size_t MX_QA = 0;
constexpr size_t MX_KA = MX_QA + (size_t)6 * R * 64 * 2;
constexpr size_t MX_QC = MX_KA + (size_t)2 * R * 64 * 2;
constexpr size_t MX_KC = MX_QC + (size_t)8 * R * 48 * 2;
constexpr size_t MX_U = MX_KC + (size_t)8 * R * 48 * 2;
constexpr size_t MX_VG = MX_U + (size_t)R * 256 * 2;
constexpr size_t MX_VT = MX_VG + (size_t)R * 256 * 2;
static_assert(MX_VT + (size_t)512 * R * 2 <= (size_t)R * FF * 2, "mixer overlay fits");

constexpr int LDS_MAIN = 131072;
constexpr int LDS_MISC = LDS_MAIN;
constexpr int LDS_BYTES = LDS_MAIN + 256;

typedef __bf16 bf16x2_t __attribute__((ext_vector_type(2)));
__device__ __forceinline__ unsigned cvt_pk_bf16(float lo, float hi) { const f32x2 v = {lo, hi}; const bf16x2_t b = __builtin_convertvector(v, bf16x2_t); return __builtin_bit_cast(unsigned, b); }
__device__ __forceinline__ float bf2f(bf16_t v) { return __uint_as_float(((unsigned)v) << 16); }
__device__ __forceinline__ float fast_exp2(float x) { return __builtin_amdgcn_exp2f(x); }
__device__ __forceinline__ float fast_rcp(float x) { return __builtin_amdgcn_rcpf(x); }
__device__ __forceinline__ float silu_f(float x) { return x * fast_rcp(1.0f + fast_exp2(-x * LOG2E)); }
__device__ __forceinline__ float gelu_tanh_f(float x) { const float u = 0.7978845608028654f * (x + 0.044715f * x * x * x); return x * fast_rcp(1.0f + fast_exp2(-2.0f * LOG2E * u)); }
template <int M> __device__ __forceinline__ float swz_xor(float v) { return __builtin_bit_cast(float, __builtin_amdgcn_ds_swizzle(__builtin_bit_cast(int, v), (M << 10) | 0x1f)); }
__device__ __forceinline__ float max3f(float a, float b, float c) { return __builtin_elementwise_maximum(__builtin_elementwise_maximum(a, b), c); }
__device__ __forceinline__ float xadd32(float v) { auto rr = __builtin_amdgcn_permlane32_swap(__float_as_uint(v), __float_as_uint(v), false, false); return __uint_as_float(rr[0]) + __uint_as_float(rr[1]); }
__device__ __forceinline__ float xmax32(float v) { auto rr = __builtin_amdgcn_permlane32_swap(__float_as_uint(v), __float_as_uint(v), false, false); const float a = __uint_as_float(rr[0]), b = __uint_as_float(rr[1]); return max3f(a, b, b); }
__device__ __forceinline__ float sum32(float v) { v += swz_xor<1>(v); v += swz_xor<2>(v); v += swz_xor<4>(v); v += swz_xor<8>(v); v += swz_xor<16>(v); return v; }
__device__ __forceinline__ float wave_sum(float v) { return xadd32(sum32(v)); }
__device__ __forceinline__ int opaque_tid() { int t = threadIdx.x; asm volatile("" : "+v"(t)); return t; }
__device__ __forceinline__ int crow(int r, int hi) { return (r & 3) + 8 * (r >> 2) + 4 * hi; }

#define XB_TMO      128
#define XB_XCNT(j)  (256  + 64 * (j))
#define XB_XSUB(j)  (1280 + 64 * (j))
#define XB_XGEN(j)  (2304 + 64 * (j))
#define XB_TOP      3328
#define XB_TOPGEN   3392
#define XCD_BAR_WORDS 3456
#define XB_SPIN_CAP (1u << 22)
__device__ __forceinline__ unsigned xb_ld(unsigned* p)              { return __hip_atomic_load(p, __ATOMIC_RELAXED, __HIP_MEMORY_SCOPE_AGENT); }
__device__ __forceinline__ unsigned xb_add(unsigned* p, unsigned v) { return __hip_atomic_fetch_add(p, v, __ATOMIC_RELAXED, __HIP_MEMORY_SCOPE_AGENT); }
__device__ __forceinline__ unsigned xb_xcc_id() { return (unsigned)__builtin_amdgcn_s_getreg((3 << 11) | 20) & 0xFu; }
#define XB_SPIN(cond, bar) do { unsigned _sp = 0; while (cond) { __builtin_amdgcn_s_sleep(1); \
    if ((++_sp & 255u) == 0u) { if (xb_ld(&(bar)[XB_TMO])) break; if (_sp > XB_SPIN_CAP) { atomicAdd(&(bar)[XB_TMO], 1u); break; } } } } while (0)
struct XcdBarrier { unsigned* bar; unsigned x; volatile LAS unsigned* st; };
__device__ __forceinline__ XcdBarrier xcd_barrier_post(unsigned* bar, volatile LAS unsigned* st) {
    XcdBarrier b; b.bar = bar; b.x = xb_xcc_id(); b.st = st;
    if (threadIdx.x == 0) (void)xb_add(&bar[XB_XCNT(b.x)], 1u);
    return b;
}
__device__ __forceinline__ void xcd_barrier_complete(unsigned* bar, unsigned x, unsigned& nloc, unsigned& nx) {
    const unsigned G = gridDim.x * gridDim.y * gridDim.z;
    unsigned sum, cnt, mine, sp = 0u;
    for (;;) {
        sum = 0u; cnt = 0u; mine = 0u;
#pragma unroll
        for (unsigned j = 0; j < 16; ++j) { const unsigned c = xb_ld(&bar[XB_XCNT(j)]); sum += c; cnt += (c > 0u) ? 1u : 0u; mine = (j == x) ? c : mine; }
        if (sum == G) break;
        __builtin_amdgcn_s_sleep(1);
        if ((++sp & 255u) == 0u) { if (xb_ld(&bar[XB_TMO])) break; if (sp > XB_SPIN_CAP) { atomicAdd(&bar[XB_TMO], 1u); break; } }
    }
    nloc = mine > 0u ? mine : 1u; nx = cnt > 0u ? cnt : 1u;
}
__device__ __forceinline__ void xcd_barrier(const XcdBarrier& b) {
    asm volatile("s_waitcnt vmcnt(0)" ::: "memory");
    __syncthreads();
    if (opaque_tid() == 0) {
        unsigned* bar = b.bar;
        __builtin_amdgcn_s_waitcnt(0);
        unsigned nloc = b.st[0], nx = b.st[1];
        if (nloc == 0u) { xcd_barrier_complete(bar, b.x, nloc, nx); b.st[0] = nloc; b.st[1] = nx; }
        const unsigned old = xb_add(&bar[XB_XSUB(b.x)], 1u);
        const unsigned gen = old / nloc;
        if (old + 1u == (gen + 1u) * nloc) {
            __builtin_amdgcn_fence(__ATOMIC_RELEASE, "agent");
            asm volatile("s_waitcnt vmcnt(0)" ::: "memory");
            const unsigned og = xb_add(&bar[XB_TOP], 1u);
            const unsigned tg = og / nx;
            if (og + 1u == (tg + 1u) * nx) xb_add(&bar[XB_TOPGEN], 1u);
            else XB_SPIN(xb_ld(&bar[XB_TOPGEN]) == tg, bar);
            __builtin_amdgcn_fence(__ATOMIC_ACQUIRE, "agent");
            xb_add(&bar[XB_XGEN(b.x)], 1u);
            asm volatile("s_waitcnt vmcnt(0)" ::: "memory");
        } else {
            XB_SPIN(xb_ld(&bar[XB_XGEN(b.x)]) == gen, bar);
            __builtin_amdgcn_fence(__ATOMIC_ACQUIRE, "agent");
            asm volatile("s_waitcnt vmcnt(0)" ::: "memory");
        }
    }
    __syncthreads();
}

namespace pg8 {
constexpr int BM = 256, BK = 64, HALF = 128, HTB = HALF * BK * 2, STAGE_BYTES = 8 * HTB, NXCD = 8, WGM = 8;
__device__ __forceinline__ int lds_byte(int r, int c) { const int st = (r >> 4) * 2 + (c >> 5), rr = r & 15, cc = c & 31, ob = rr * 64 + cc * 2; return st * 1024 + (ob ^ (((ob >> 9) & 1) << 5)); }
__device__ __forceinline__ void stage_rc(int b, int& Rr, int& C) { const int st = b / 1024, sb = b % 1024, swz = sb ^ (((sb >> 9) & 1) << 5); Rr = (st >> 1) * 16 + swz / 64; C = (st & 1) * 32 + (swz % 64) / 2; }
__device__ __forceinline__ int perm32(int rho) { const int n = rho >> 4, i = rho & 15; return 8 * (i >> 2) + 4 * n + (i & 3); }

struct Unit { const char* a; const char* b; int pm, pn, kind, nt; };

__device__ __forceinline__ void order_map(int L, int nM, int nN, int& pm, int& pn) {
    const int nwg = nM * nN; int wgid = L;
    { const int q = nwg / NXCD, r = nwg % NXCD, xcd = wgid % NXCD, off = wgid / NXCD; wgid = (xcd < r ? xcd * (q + 1) : r * (q + 1) + (xcd - r) * q) + off; }
    const int nig = WGM * nN, gid = wgid / nig, fm = gid * WGM, gsz = (nM - fm) < WGM ? (nM - fm) : WGM;
    pm = fm + ((wgid % nig) % gsz); pn = (wgid % nig) / gsz;
}
struct SchedOne {
    const char* A; const char* B; int nM, nN, G, c; size_t tstep; int nt;
    __device__ __forceinline__ bool next(int i, Unit& u) const {
        const long L = (long)i * G + c; if (L >= (long)nM * nN) return false;
        int pm, pn; order_map((int)L, nM, nN, pm, pn);
        u.pm = pm; u.pn = pn; u.kind = 0; u.nt = nt; u.a = A + (size_t)pm * tstep; u.b = B + (size_t)pn * tstep; return true;
    }
};
struct SchedDown {
    const char* A; const char* B; int G, c; size_t tstep; int nt, nctx, nsplit, ntc;
    __device__ __forceinline__ bool next(int i, Unit& u) const {
        const long L = (long)i * G + c; constexpr int n1 = 128 * 4; const int nsub = nctx * 4 * nsplit;
        if (L >= n1 + nsub) return false;
        int pm, pn;
        if (L >= nsub) { order_map((int)L - nsub, 128, 4, pm, pn); u.kind = 0; u.nt = nt; u.a = A + (size_t)pm * tstep; u.b = B + (size_t)pn * tstep; }
        else { const int j = (int)L, ks = j % nsplit, tile = j / nsplit; pm = 128 + (tile >> 2); pn = tile & 3; u.kind = 1 + ks; u.nt = ntc;
               u.a = A + (size_t)pm * tstep + (size_t)ks * ntc * 128; u.b = B + (size_t)pn * tstep + (size_t)ks * ntc * 128; }
        u.pm = pm; u.pn = pn; return true;
    }
};
struct SchedMix {
    const char* H; const char* Wm; const char* Wv; int G, c; size_t tstep;
    __device__ __forceinline__ bool next(int i, Unit& u) const {
        const long L = (long)i * G + c; constexpr int n1 = 132 * 7, n2 = 2 * 132;
        if (L >= n1 + n2) return false;
        int pm, pn;
        if (L < n1) { order_map((int)L, 132, 7, pm, pn); u.kind = 0; u.nt = 16; u.a = H + (size_t)pm * tstep; u.b = Wm + (size_t)pn * tstep; }
        else { order_map((int)L - n1, 2, 132, pm, pn); u.kind = 1; u.nt = 16; u.a = Wv + (size_t)pm * tstep; u.b = H + (size_t)pn * tstep; }
        u.pm = pm; u.pn = pn; return true;
    }
};

template <class Epi, class Sched, bool ALIGN_EPI = true, bool SP2 = true>
__device__ __forceinline__ void gemm_phase(LAS unsigned char* lds, const int K, const Sched& S, const Epi& E) {
    const int tid = opaque_tid(), wid = __builtin_amdgcn_readfirstlane(tid >> 6), lane = tid & 63, wr = wid >> 2, wc = wid & 3, fr = lane & 15, fq = lane >> 4;
    unsigned voffA[2], voffB[2];
#pragma unroll
    for (int i = 0; i < 2; ++i) { int Rr, C; stage_rc(tid * 16 + i * 8192, Rr, C); const int Rb = Epi::PERM ? ((Rr & ~31) + perm32(Rr & 31)) : Rr;
        voffA[i] = (unsigned)(Rr * K + C) * 2u; voffB[i] = (unsigned)(Rb * K + C) * 2u; }
    const size_t kstep = (size_t)(BK * 2);
    const size_t hstep = (size_t)HALF * K * 2;
    const unsigned ldsw = (unsigned)wid * 1024u;
    const int aoff = lds_byte(wr * 64 + fr, fq * 8), boff = lds_byte(wc * 32 + fr, fq * 8);
#define PG8_SA(b, h) (((b) * 2 + (h)) * HTB)
#define PG8_SB(b, h) ((4 + (b) * 2 + (h)) * HTB)
#define PG8_STAGE(bufoff, gbase, voff) do { _Pragma("unroll") for (int _i = 0; _i < 2; ++_i) \
        __builtin_amdgcn_global_load_lds((const unsigned*)((const char*)(gbase) + (voff)[_i]), (LAS unsigned*)(lds + (bufoff) + ldsw + _i * 8192), 16, 0, 0); } while (0)
#define PG8_LDA(dst, b, h) do { _Pragma("unroll") for (int m = 0; m < 4; ++m) _Pragma("unroll") for (int k = 0; k < 2; ++k) dst[m][k] = *(const LAS bf16x8*)(lds + PG8_SA(b, h) + aoff + m * 2048 + k * 1024); } while (0)
#define PG8_LDB(dst, b, h) do { _Pragma("unroll") for (int n = 0; n < 2; ++n) _Pragma("unroll") for (int k = 0; k < 2; ++k) dst[n][k] = *(const LAS bf16x8*)(lds + PG8_SB(b, h) + boff + n * 2048 + k * 1024); } while (0)
#define PG8_MMA(ai, bj, At, Bt) do { __builtin_amdgcn_s_setprio(1); _Pragma("unroll") for (int m = 0; m < 4; ++m) _Pragma("unroll") for (int n = 0; n < 2; ++n) _Pragma("unroll") for (int k = 0; k < 2; ++k) \
        acc[ai][bj][m][n] = __builtin_amdgcn_mfma_f32_16x16x32_bf16(Bt[n][k], At[m][k], acc[ai][bj][m][n], 0, 0, 0); __builtin_amdgcn_s_setprio(0); } while (0)
#define PG8_WAIT_V(n) asm volatile("s_waitcnt vmcnt(" #n ")" ::: "memory")
#define PG8_WAIT_L(n) asm volatile("s_waitcnt lgkmcnt(" #n ")" ::: "memory")
#define PG8_BAR __builtin_amdgcn_s_barrier()
#define PG8_SCHED __builtin_amdgcn_sched_barrier(0)
    Unit cur, nxt; int ui = 0;
    if (!S.next(0, cur)) return;
    f32x4 acc[2][2][4][2];
#pragma unroll
    for (int a = 0; a < 2; ++a)
#pragma unroll
        for (int b = 0; b < 2; ++b)
#pragma unroll
            for (int m = 0; m < 4; ++m)
#pragma unroll
                for (int n = 0; n < 2; ++n) acc[a][b][m][n] = (f32x4){0.f, 0.f, 0.f, 0.f};
    bf16x8 At[4][2], B0[2][2], B1[2][2];
    const char* cA = cur.a; const char* cB = cur.b;
    if constexpr (SP2) {
        PG8_STAGE(PG8_SB(0, 0), cB, voffB); PG8_STAGE(PG8_SB(0, 1), cB + hstep, voffB); PG8_STAGE(PG8_SA(0, 0), cA, voffA); PG8_STAGE(PG8_SA(0, 1), cA + hstep, voffA);
        if (wr == 1) PG8_BAR;
        PG8_WAIT_V(2); PG8_BAR;
        PG8_STAGE(PG8_SB(1, 0), cB + kstep, voffB); PG8_STAGE(PG8_SA(1, 0), cA + kstep, voffA); PG8_STAGE(PG8_SB(1, 1), cB + hstep + kstep, voffB);
        PG8_WAIT_V(6); PG8_BAR;
    } else {
        PG8_STAGE(PG8_SB(0, 0), cB, voffB); PG8_STAGE(PG8_SA(0, 0), cA, voffA); PG8_STAGE(PG8_SB(0, 1), cB + hstep, voffB); PG8_STAGE(PG8_SA(0, 1), cA + hstep, voffA);
        if (wr == 1) PG8_BAR;
        PG8_WAIT_V(4); PG8_BAR;
        PG8_STAGE(PG8_SB(1, 0), cB + kstep, voffB); PG8_STAGE(PG8_SA(1, 0), cA + kstep, voffA); PG8_STAGE(PG8_SB(1, 1), cB + hstep + kstep, voffB);
        PG8_WAIT_V(6); PG8_BAR;
    }
    for (;;) {
        const bool has_next = S.next(ui + 1, nxt);
        const char* nA = has_next ? nxt.a : cA; const char* nB = has_next ? nxt.b : cB;
        const int nt = cur.nt;
        for (int t = 0; t < nt; t += 2) {
            const bool last = (t == nt - 2);
            const char* a1 = cA + (size_t)(t + 1) * kstep;
            const char* a2 = last ? nA : cA + (size_t)(t + 2) * kstep; const char* b2 = last ? nB : cB + (size_t)(t + 2) * kstep;
            const char* a3 = a2 + kstep; const char* b3 = b2 + kstep;
            if constexpr (SP2) {
            PG8_LDB(B0, 0, 0); PG8_LDB(B1, 0, 1); PG8_SCHED; PG8_LDA(At, 0, 0); PG8_STAGE(PG8_SA(1, 1), a1 + hstep, voffA);
            PG8_WAIT_V(8); PG8_WAIT_L(0); PG8_BAR; PG8_MMA(0, 0, At, B0); PG8_MMA(0, 1, At, B1); PG8_BAR; PG8_SCHED;
            PG8_LDA(At, 0, 1); PG8_STAGE(PG8_SB(0, 0), b2, voffB); PG8_STAGE(PG8_SB(0, 1), b2 + hstep, voffB); PG8_STAGE(PG8_SA(0, 0), a2, voffA);
            PG8_WAIT_V(8); PG8_WAIT_L(0); PG8_BAR; PG8_MMA(1, 0, At, B0); PG8_MMA(1, 1, At, B1); PG8_BAR; PG8_SCHED;
            PG8_LDB(B0, 1, 0); PG8_LDB(B1, 1, 1); PG8_SCHED; PG8_LDA(At, 1, 0); PG8_STAGE(PG8_SA(0, 1), a2 + hstep, voffA);
            PG8_WAIT_V(8); PG8_WAIT_L(0); PG8_BAR; PG8_MMA(0, 0, At, B0); PG8_MMA(0, 1, At, B1); PG8_BAR; PG8_SCHED;
            PG8_LDA(At, 1, 1); PG8_STAGE(PG8_SB(1, 0), b3, voffB); PG8_STAGE(PG8_SB(1, 1), b3 + hstep, voffB); PG8_STAGE(PG8_SA(1, 0), a3, voffA);
            PG8_WAIT_V(8); PG8_WAIT_L(0); PG8_BAR; PG8_MMA(1, 0, At, B0); PG8_MMA(1, 1, At, B1); PG8_BAR; PG8_SCHED;
            } else {
            PG8_LDB(B0, 0, 0); PG8_SCHED; PG8_LDA(At, 0, 0); PG8_STAGE(PG8_SA(1, 1), a1 + hstep, voffA);
            PG8_WAIT_L(8); PG8_BAR; PG8_WAIT_L(0); PG8_MMA(0, 0, At, B0); PG8_BAR; PG8_SCHED;
            PG8_LDB(B1, 0, 1); PG8_STAGE(PG8_SB(0, 0), b2, voffB);
            PG8_BAR; PG8_WAIT_L(0); PG8_MMA(0, 1, At, B1); PG8_BAR;
            PG8_LDA(At, 0, 1); PG8_STAGE(PG8_SA(0, 0), a2, voffA);
            PG8_BAR; PG8_WAIT_L(0); PG8_MMA(1, 0, At, B0); PG8_BAR; PG8_SCHED;
            PG8_STAGE(PG8_SB(0, 1), b2 + hstep, voffB);
            PG8_WAIT_V(6); PG8_BAR; PG8_MMA(1, 1, At, B1); PG8_BAR;
            PG8_LDB(B0, 1, 0); PG8_SCHED; PG8_LDA(At, 1, 0); PG8_STAGE(PG8_SA(0, 1), a2 + hstep, voffA);
            PG8_WAIT_L(8); PG8_BAR; PG8_WAIT_L(0); PG8_MMA(0, 0, At, B0); PG8_BAR; PG8_SCHED;
            PG8_LDB(B1, 1, 1); PG8_STAGE(PG8_SB(1, 0), b3, voffB);
            PG8_BAR; PG8_WAIT_L(0); PG8_MMA(0, 1, At, B1); PG8_BAR;
            PG8_LDA(At, 1, 1); PG8_STAGE(PG8_SA(1, 0), a3, voffA);
            PG8_BAR; PG8_WAIT_L(0); PG8_MMA(1, 0, At, B0); PG8_BAR; PG8_SCHED;
            PG8_STAGE(PG8_SB(1, 1), b3 + hstep, voffB);
            PG8_WAIT_V(6); PG8_BAR; PG8_MMA(1, 1, At, B1); PG8_BAR;
            }
        }
        if constexpr (ALIGN_EPI) { if (wr == 0) PG8_BAR; }
        E(acc, cur, wr, wc, fr, fq);
        if (!has_next) break;
#pragma unroll
        for (int a = 0; a < 2; ++a)
#pragma unroll
            for (int b = 0; b < 2; ++b)
#pragma unroll
                for (int m = 0; m < 4; ++m)
#pragma unroll
                    for (int n = 0; n < 2; ++n) acc[a][b][m][n] = (f32x4){0.f, 0.f, 0.f, 0.f};
        cur = nxt; cA = nA; cB = nB; ++ui;
        if constexpr (ALIGN_EPI) { if (wr == 1) PG8_BAR; }
    }
    PG8_WAIT_V(0);
    if constexpr (!ALIGN_EPI) { if (wr == 0) PG8_BAR; }
    PG8_BAR;
#undef PG8_SA
#undef PG8_SB
#undef PG8_STAGE
#undef PG8_LDA
#undef PG8_LDB
#undef PG8_MMA
#undef PG8_WAIT_V
#undef PG8_WAIT_L
#undef PG8_BAR
#undef PG8_SCHED
}

struct EpiUp {
    static constexpr bool PERM = true;
    bf16_t* act;
    __device__ __forceinline__ void operator()(const f32x4 (&acc)[2][2][4][2], const Unit& u, int wr, int wc, int fr, int fq) const {
        asm volatile("" : "+v"(fr), "+v"(fq));
        const int row0 = u.pm * BM + wr * 64 + fr; const int col0 = u.pn * 128 + wc * 32 + 8 * fq;
#pragma unroll
        for (int ai = 0; ai < 2; ++ai)
#pragma unroll
            for (int m = 0; m < 4; ++m) {
                bf16_t* rowp = act + (size_t)(row0 + ai * HALF + m * 16) * FF + col0;
                const f32x4 g0 = acc[ai][0][m][0], g1 = acc[ai][0][m][1], u0 = acc[ai][1][m][0], u1 = acc[ai][1][m][1];
                u32x4 w;
                w.x = cvt_pk_bf16(silu_f(g0[0]) * u0[0], silu_f(g0[1]) * u0[1]); w.y = cvt_pk_bf16(silu_f(g0[2]) * u0[2], silu_f(g0[3]) * u0[3]);
                w.z = cvt_pk_bf16(silu_f(g1[0]) * u1[0], silu_f(g1[1]) * u1[1]); w.w = cvt_pk_bf16(silu_f(g1[2]) * u1[2], silu_f(g1[3]) * u1[3]);
                *(u32x4*)rowp = w;
            }
    }
};
struct EpiDown {
    static constexpr bool PERM = true;
    const float* xoldL; const float* xoldC; float* xnew; const float* gate; float gscale; float* part;
    __device__ __forceinline__ void operator()(const f32x4 (&acc)[2][2][4][2], const Unit& u, int wr, int wc, int fr, int fq) const {
        asm volatile("" : "+v"(fr), "+v"(fq));
        const int s = u.pm < 128 ? (u.pm >> 5) : 4;
        const int row0 = u.pm * BM + wr * 64 + fr; const int col0 = u.pn * BM + wc * 32 + 8 * fq;
        const float* xo = (u.pm < 128) ? xoldL + (size_t)row0 * DM : xoldC + (size_t)(row0 - RL) * DM;
        float* xn = xnew + (size_t)row0 * DM;
        const bool partial = (u.kind >= 1);
        float* pp = part + ((size_t)(u.kind - 1) * RC + (row0 - RL)) * DM;
        f32x4 gv[2][2];
#pragma unroll
        for (int bj = 0; bj < 2; ++bj)
#pragma unroll
            for (int n = 0; n < 2; ++n) gv[bj][n] = *(const f32x4*)(gate + (size_t)s * 9216 + col0 + bj * HALF + 4 * n) * gscale;
        if (partial) {
#pragma unroll
            for (int ai = 0; ai < 2; ++ai)
#pragma unroll
                for (int m = 0; m < 4; ++m) {
                    const size_t ro = (size_t)(ai * HALF + m * 16) * DM + col0;
#pragma unroll
                    for (int bj = 0; bj < 2; ++bj)
#pragma unroll
                        for (int n = 0; n < 2; ++n) *(f32x4*)(pp + ro + bj * HALF + 4 * n) = acc[ai][bj][m][n];
                }
        } else {
#pragma unroll
            for (int ai = 0; ai < 2; ++ai) {
                f32x4 xv[4][2][2];
#pragma unroll
                for (int m = 0; m < 4; ++m)
#pragma unroll
                    for (int bj = 0; bj < 2; ++bj)
#pragma unroll
                        for (int n = 0; n < 2; ++n) xv[m][bj][n] = *(const f32x4*)(xo + (size_t)(ai * HALF + m * 16) * DM + col0 + bj * HALF + 4 * n);
                __builtin_amdgcn_sched_barrier(0);
#pragma unroll
                for (int m = 0; m < 4; ++m)
#pragma unroll
                    for (int bj = 0; bj < 2; ++bj)
#pragma unroll
                        for (int n = 0; n < 2; ++n) *(f32x4*)(xn + (size_t)(ai * HALF + m * 16) * DM + col0 + bj * HALF + 4 * n) = xv[m][bj][n] + gv[bj][n] * acc[ai][bj][m][n];
                __builtin_amdgcn_sched_barrier(0);
            }
        }
    }
};
struct EpiMix {
    static constexpr bool PERM = true;
    unsigned char* mx;
    const float* gq; const float* gk;
    __device__ __forceinline__ void operator()(const f32x4 (&acc)[2][2][4][2], const Unit& u, int wr, int wc, int fr, int fq) const {
        asm volatile("" : "+v"(fr), "+v"(fq));
        if (u.kind == 1) {
            bf16_t* O = (bf16_t*)(mx + MX_VT);
            const int row0 = u.pm * BM + wr * 64 + fr, col0 = u.pn * BM + wc * 32 + 8 * fq;
#pragma unroll
            for (int ai = 0; ai < 2; ++ai)
#pragma unroll
                for (int m = 0; m < 4; ++m) { bf16_t* rowp = O + (size_t)(row0 + ai * HALF + m * 16) * R + col0;
#pragma unroll
                    for (int bj = 0; bj < 2; ++bj) { const f32x4 v0 = acc[ai][bj][m][0], v1 = acc[ai][bj][m][1]; u32x4 w;
                        w.x = cvt_pk_bf16(v0[0], v0[1]); w.y = cvt_pk_bf16(v0[2], v0[3]); w.z = cvt_pk_bf16(v1[0], v1[1]); w.w = cvt_pk_bf16(v1[2], v1[3]);
                        *(u32x4*)(rowp + bj * HALF) = w; } }
            return;
        }
        const int row0 = u.pm * BM + wr * 64 + fr;
        const bool latent = u.pm < 128;
        if (u.pn <= 1) {
            const int slot = u.pn * 4 + wc; const bool isq = slot < 6;
            const float* g = isq ? gq : gk;
            bf16_t* dst = isq ? (bf16_t*)(mx + MX_QA) + (size_t)slot * R * 64 : (bf16_t*)(mx + MX_KA) + (size_t)(slot - 6) * R * 64;
            float fr0[2], fr1[2];
#pragma unroll
            for (int n = 0; n < 2; ++n) { const float p = (float)(4 * fq + 2 * n);
                fr0[n] = fast_exp2(-p * (13.287712379549449f / 16.0f)) * 0.15915494309189535f; fr1[n] = fast_exp2(-(p + 1.0f) * (13.287712379549449f / 16.0f)) * 0.15915494309189535f; }
#pragma unroll
            for (int ai = 0; ai < 2; ++ai)
#pragma unroll
                for (int m = 0; m < 4; ++m) {
                    const int row = row0 + ai * HALF + m * 16;
                    int fqo = fq; asm volatile("" : "+v"(fqo));
                    f32x4 v[2][2]; float ss = 0.f;
#pragma unroll
                    for (int bj = 0; bj < 2; ++bj)
#pragma unroll
                        for (int n = 0; n < 2; ++n) { v[bj][n] = acc[ai][bj][m][n]; ss += (v[bj][n][0] * v[bj][n][0] + v[bj][n][1] * v[bj][n][1]) + (v[bj][n][2] * v[bj][n][2] + v[bj][n][3] * v[bj][n][3]); }
                    ss += swz_xor<16>(ss); ss = xadd32(ss);
                    const float rstd = __builtin_amdgcn_rsqf(ss * (1.0f / 64.0f) + EPS);
                    const int t = row & (SEQ - 1); const float pos[2] = {(float)(t >> 6), (float)(t & 63)};
#pragma unroll
                    for (int bj = 0; bj < 2; ++bj) {
                        u32x4 w;
#pragma unroll
                        for (int n = 0; n < 2; ++n) {
                            f32x4 x = v[bj][n] * rstd * *(const f32x4*)(g + 32 * bj + 8 * fqo + 4 * n);
                            if (latent) {
                                const float a0 = pos[bj] * fr0[n], a1 = pos[bj] * fr1[n];
                                const float c0 = __builtin_amdgcn_cosf(a0), s0 = __builtin_amdgcn_sinf(a0), c1 = __builtin_amdgcn_cosf(a1), s1 = __builtin_amdgcn_sinf(a1);
                                x = (f32x4){x[0] * c0 - x[1] * s0, x[1] * c0 + x[0] * s0, x[2] * c1 - x[3] * s1, x[3] * c1 + x[2] * s1};
                            }
                            if (n == 0) { w.x = cvt_pk_bf16(x[0], x[1]); w.y = cvt_pk_bf16(x[2], x[3]); } else { w.z = cvt_pk_bf16(x[0], x[1]); w.w = cvt_pk_bf16(x[2], x[3]); }
                        }
                        *(u32x4*)(dst + (size_t)row * 64 + 32 * bj + 8 * fq) = w;
                    }
                    __builtin_amdgcn_sched_barrier(0);
                }
        } else if (u.pn <= 3) {
            bf16_t* dst = (bf16_t*)(mx + (u.pn == 2 ? MX_U : MX_VG));
            const int col0 = wc * 32 + 8 * fq;
#pragma unroll
            for (int ai = 0; ai < 2; ++ai)
#pragma unroll
                for (int m = 0; m < 4; ++m) { bf16_t* rowp = dst + (size_t)(row0 + ai * HALF + m * 16) * 256 + col0;
#pragma unroll
                    for (int bj = 0; bj < 2; ++bj) { const f32x4 v0 = acc[ai][bj][m][0], v1 = acc[ai][bj][m][1]; u32x4 w;
                        w.x = cvt_pk_bf16(gelu_tanh_f(v0[0]), gelu_tanh_f(v0[1])); w.y = cvt_pk_bf16(gelu_tanh_f(v0[2]), gelu_tanh_f(v0[3]));
                        w.z = cvt_pk_bf16(gelu_tanh_f(v1[0]), gelu_tanh_f(v1[1])); w.w = cvt_pk_bf16(gelu_tanh_f(v1[2]), gelu_tanh_f(v1[3]));
                        *(u32x4*)(rowp + bj * HALF) = w; } }
        } else {
#pragma unroll
            for (int bj = 0; bj < 2; ++bj) {
                const int j = (u.pn - 4) * 256 + 128 * bj + 32 * wc + 8 * fq;
                const int which = j >= 384 ? 1 : 0; const int rem = j - which * 384; const int ch = rem / 48; const int sidx = rem - ch * 48;
                const int blk = sidx >= 24 ? 1 : 0; const int ii = sidx - blk * 24;
                bf16_t* dst = (bf16_t*)(mx + (which ? MX_KC : MX_QC)) + (size_t)ch * R * 48 + sidx;
                const float qs = which ? 1.0f : 0.14433756729740643f * LOG2E;
                float fq4[4];
#pragma unroll
                for (int e = 0; e < 4; ++e) fq4[e] = fast_exp2(-(float)(ii / 2 + e) * (13.287712379549449f / 12.0f)) * 0.15915494309189535f;
#pragma unroll
                for (int ai = 0; ai < 2; ++ai)
#pragma unroll
                    for (int m = 0; m < 4; ++m) {
                        const int row = row0 + ai * HALF + m * 16;
                        f32x4 x0 = acc[ai][bj][m][0] * qs, x1 = acc[ai][bj][m][1] * qs;
                        if (latent) {
                            const int t = row & (SEQ - 1); const float pos = blk ? (float)(t & 63) : (float)(t >> 6);
                            const float a0 = pos * fq4[0], a1 = pos * fq4[1], a2 = pos * fq4[2], a3 = pos * fq4[3];
                            const float c0 = __builtin_amdgcn_cosf(a0), s0 = __builtin_amdgcn_sinf(a0), c1 = __builtin_amdgcn_cosf(a1), s1 = __builtin_amdgcn_sinf(a1);
                            const float c2 = __builtin_amdgcn_cosf(a2), s2 = __builtin_amdgcn_sinf(a2), c3 = __builtin_amdgcn_cosf(a3), s3 = __builtin_amdgcn_sinf(a3);
                            x0 = (f32x4){x0[0] * c0 - x0[1] * s0, x0[1] * c0 + x0[0] * s0, x0[2] * c1 - x0[3] * s1, x0[3] * c1 + x0[2] * s1};
                            x1 = (f32x4){x1[0] * c2 - x1[1] * s2, x1[1] * c2 + x1[0] * s2, x1[2] * c3 - x1[3] * s3, x1[3] * c3 + x1[2] * s3};
                        }
                        u32x4 w; w.x = cvt_pk_bf16(x0[0], x0[1]); w.y = cvt_pk_bf16(x0[2], x0[3]); w.z = cvt_pk_bf16(x1[0], x1[1]); w.w = cvt_pk_bf16(x1[2], x1[3]);
                        *(u32x4*)(dst + (size_t)row * 48) = w;
                        __builtin_amdgcn_sched_barrier(0);
                    }
            }
        }
    }
};
}

struct Args { const float* in[23]; float* out; unsigned char* ws; };
enum { I_X = 0, I_C, I_CTX, I_CCTX, I_WMOD, I_BMOD, I_GFFN1, I_W1IN, I_W1OUT, I_GMIX, I_WMIXIN, I_WMIXOUT, I_GQ, I_GK, I_GV, I_WS, I_BS, I_LAM, I_GSUB, I_GFFN2, I_W2IN, I_W2OUT, I_GFINAL };

__device__ __forceinline__ int ffn_in_src(int n) { const int pn = n >> 8, j = n & 255, bj = j >> 7, jj = j & 127; return bj * FF + pn * 128 + jj; }
__device__ __forceinline__ int mix_in_src(int n) {
    if (n < 512) { const int tile = n >> 8, j = n & 255, bj = j >> 7, wc = (j & 127) >> 5, i = j & 31; const int slot = tile * 4 + wc; return slot * 64 + bj * 32 + (i >> 1) + 16 * (i & 1); }
    if (n < 768) return 640 + (n - 512);
    if (n < 1024) return 896 + (n - 768);
    if (n < 1792) { const int j = n - 1024, which = j >= 384 ? 1 : 0, rem = j - which * 384, ch = rem / 48, sidx = rem - ch * 48, blk = sidx >= 24 ? 1 : 0, ii = sidx - blk * 24;
        return (which ? 1536 : 1152) + ch * 48 + blk * 24 + (ii >> 1) + 12 * (ii & 1); }
    const int v = n - 1792; return v < 128 ? 512 + v : 1920 + (v - 128);
}
template <int MAP>
__device__ __forceinline__ void transpose_item(const float* W, int K, int N, bf16_t* WT, LAS float* scr, int item, int nblk, int lane) {
    const int kb = item / nblk, nb = item % nblk, k0 = 64 * kb, n0 = 32 * nb;
    const bool contig = (MAP == 0) || (MAP == 1) || (n0 >= 512 && n0 < 1024) || (n0 >= 1792);
    if (contig) {
        const int src0 = MAP == 0 ? n0 : (MAP == 1 ? ffn_in_src(n0) : mix_in_src(n0));
        const int c4 = lane & 7; f32x4 v[8];
#pragma unroll
        for (int i = 0; i < 8; ++i) v[i] = *(const f32x4*)(W + (size_t)(k0 + (lane >> 3) + 8 * i) * N + src0 + 4 * c4);
#pragma unroll
        for (int i = 0; i < 8; ++i) { LAS float* d = scr + ((lane >> 3) + 8 * i) * 33 + 4 * c4; d[0] = v[i][0]; d[1] = v[i][1]; d[2] = v[i][2]; d[3] = v[i][3]; }
    } else {
        const int nn = n0 + (lane & 31); const int src = MAP == 0 ? nn : (MAP == 1 ? ffn_in_src(nn) : mix_in_src(nn));
#pragma unroll 8
        for (int i = 0; i < 32; ++i) { const int kk = 2 * i + (lane >> 5); scr[kk * 33 + (lane & 31)] = W[(size_t)(k0 + kk) * N + src]; }
    }
    asm volatile("s_waitcnt lgkmcnt(0)" ::: "memory");
    const int c = lane & 7;
#pragma unroll
    for (int j = 0; j < 4; ++j) { const int n = (lane >> 3) + 8 * j; const LAS float* s = scr + (8 * c) * 33 + n;
        u32x4 o; o.x = cvt_pk_bf16(s[0 * 33], s[1 * 33]); o.y = cvt_pk_bf16(s[2 * 33], s[3 * 33]); o.z = cvt_pk_bf16(s[4 * 33], s[5 * 33]); o.w = cvt_pk_bf16(s[6 * 33], s[7 * 33]);
        *(u32x4*)(WT + (size_t)(n0 + n) * K + k0 + 8 * c) = o; }
    asm volatile("s_waitcnt lgkmcnt(0)" ::: "memory");
}

__device__ __forceinline__ void phase0(const Args& a, LAS unsigned char* lds, int tid, int lane, int wave) {
    const int G = gridDim.x;
    {
        LAS float* sc = (LAS float*)lds;
        LAS float* red = (LAS float*)(lds + 5 * 1024 * 4);
        for (int i = tid; i < 5 * 1024; i += NTHREADS) { const int s = i >> 10, k = i & 1023; const float v = s < 4 ? a.in[I_C][s * 1024 + k] : a.in[I_CCTX][k]; sc[i] = silu_f(v); }
        __syncthreads();
        float* modv = (float*)(a.ws + WS_MODV);
        for (int u = blockIdx.x; u < DEPTH * 72; u += G) {
            const int l = u / 72, n0 = (u % 72) * 128; const int kq = tid >> 7, col = tid & 127;
            const float* W = a.in[I_WMOD] + (size_t)l * 1024 * 9216 + n0 + col;
            float acc[5] = {0.f, 0.f, 0.f, 0.f, 0.f};
#pragma unroll 8
            for (int k = kq; k < 1024; k += 4) { const float w = W[(size_t)k * 9216];
#pragma unroll
                for (int s = 0; s < 5; ++s) acc[s] += sc[s * 1024 + k] * w; }
#pragma unroll
            for (int s = 0; s < 5; ++s) red[(kq * 5 + s) * 128 + col] = acc[s];
            __syncthreads();
            for (int i = tid; i < 5 * 128; i += NTHREADS) { const int s = i >> 7, c = i & 127;
                const float v = red[(0 * 5 + s) * 128 + c] + red[(1 * 5 + s) * 128 + c] + red[(2 * 5 + s) * 128 + c] + red[(3 * 5 + s) * 128 + c];
                modv[((size_t)l * 5 + s) * 9216 + n0 + c] = v + a.in[I_BMOD][(size_t)l * 9216 + n0 + c]; }
            __syncthreads();
        }
    }
    {
        float* xc = (float*)(a.ws + WS_XRES) + (size_t)RL * DM;
        for (int i = blockIdx.x * NTHREADS + tid; i < RC * DM / 4; i += G * NTHREADS) ((f32x4*)xc)[i] = ((const f32x4*)a.in[I_CTX])[i];
    }
    if (blockIdx.x == 0) {
        float* gt = (float*)(a.ws + WS_GTAB);
        for (int i = tid; i < DEPTH * 128; i += NTHREADS) { const int l = i >> 7, isk = (i >> 6) & 1, sidx = i & 63, bj = sidx >> 5, ii = sidx & 31;
            const int tc = 32 * bj + (ii >> 1) + 16 * (ii & 1);
            gt[i] = isk ? a.in[I_GK][l * 64 + tc] : a.in[I_GQ][l * 64 + tc] * (0.125f * LOG2E); }
    }
    __syncthreads();
    {
        LAS float* scr = (LAS float*)(lds + wave * 16384);
        const int gw = blockIdx.x * NWAVES + wave, NGW = G * NWAVES;
        constexpr int I1 = 16 * 176, I2 = 44 * 32, I3 = 16 * 72, I4 = 16 * 32;
        constexpr int PER_LAYER = I1 + I2 + I3 + I4 + I1 + I2;
        for (int it = gw; it < DEPTH * PER_LAYER; it += NGW) {
            const int l = it / PER_LAYER; int r = it % PER_LAYER;
            unsigned char* wl = a.ws + WS_W + (size_t)l * LAYER_W_BYTES;
            if (r < I1) { transpose_item<1>(a.in[I_W1IN] + (size_t)l * 1024 * 5632, 1024, 5632, (bf16_t*)(wl + W_1IN), scr, r, 176, lane); continue; } r -= I1;
            if (r < I2) { transpose_item<0>(a.in[I_W1OUT] + (size_t)l * 2816 * 1024, 2816, 1024, (bf16_t*)(wl + W_1OUT), scr, r, 32, lane); continue; } r -= I2;
            if (r < I3) { transpose_item<2>(a.in[I_WMIXIN] + (size_t)l * 1024 * 2304, 1024, 2304, (bf16_t*)(wl + W_MIX), scr, r, 72, lane); continue; } r -= I3;
            if (r < I4) { transpose_item<0>(a.in[I_WMIXOUT] + (size_t)l * 1024 * 1024, 1024, 1024, (bf16_t*)(wl + W_OUT), scr, r, 32, lane); continue; } r -= I4;
            if (r < I1) { transpose_item<1>(a.in[I_W2IN] + (size_t)l * 1024 * 5632, 1024, 5632, (bf16_t*)(wl + W_2IN), scr, r, 176, lane); continue; } r -= I1;
            transpose_item<0>(a.in[I_W2OUT] + (size_t)l * 2816 * 1024, 2816, 1024, (bf16_t*)(wl + W_2OUT), scr, r, 32, lane);
        }
    }
}

__device__ __forceinline__ void norm_row(const f32x4 (&v)[4], const f32x4 (&gn)[4], const float* sh, bf16_t* hrow, int lane) {
    const float* scl = sh + 1024;
    f32x4 sv[4], cv[4];
#pragma unroll
    for (int j = 0; j < 4; ++j) { sv[j] = *(const f32x4*)(sh + 4 * lane + 256 * j); cv[j] = *(const f32x4*)(scl + 4 * lane + 256 * j); }
    float ss = 0.f;
#pragma unroll
    for (int j = 0; j < 4; ++j) ss += (v[j][0] * v[j][0] + v[j][1] * v[j][1]) + (v[j][2] * v[j][2] + v[j][3] * v[j][3]);
    const float rstd = __builtin_amdgcn_rsqf(wave_sum(ss) * (1.0f / DM) + EPS);
#pragma unroll
    for (int j = 0; j < 4; ++j) {
        const f32x4 y = v[j] * rstd * gn[j] * (cv[j] + 1.0f) + sv[j];
        u32x2 w; w.x = cvt_pk_bf16(y[0], y[1]); w.y = cvt_pk_bf16(y[2], y[3]);
        *(u32x2*)(hrow + 4 * lane + 256 * j) = w;
    }
}
__device__ __forceinline__ void norm_phase(const float* xL, const float* xC, const float* gain, const float* modl  , int ishift, bf16_t* H, int nrows,
                                           const float* part, int nsplit, const float* pgate  , float pscale, float* xCw) {
    const int tid_ = opaque_tid(); const int lane = tid_ & 63, wave = __builtin_amdgcn_readfirstlane(tid_ >> 6);
    const int gw = blockIdx.x * NWAVES + wave, NGW = gridDim.x * NWAVES;
    f32x4 gn[4];
#pragma unroll
    for (int j = 0; j < 4; ++j) gn[j] = *(const f32x4*)(gain + 4 * lane + 256 * j);
    const int nplain = (nsplit > 0 && nrows > RL) ? RL : nrows;
    {
        int row = gw; f32x4 v[4], vn[4];
        if (row < nplain) { const float* xr = row < RL ? xL + (size_t)row * DM : xC + (size_t)(row - RL) * DM;
#pragma unroll
            for (int j = 0; j < 4; ++j) v[j] = *(const f32x4*)(xr + 4 * lane + 256 * j); }
        for (; row < nplain; row += NGW) {
            const int rn = row + NGW;
            if (rn < nplain) { const float* xr = rn < RL ? xL + (size_t)rn * DM : xC + (size_t)(rn - RL) * DM;
#pragma unroll
                for (int j = 0; j < 4; ++j) vn[j] = *(const f32x4*)(xr + 4 * lane + 256 * j); }
            const int s = row < RL ? (row >> 13) : 4;
            norm_row(v, gn, modl + (size_t)s * 9216 + ishift * 1024, H + (size_t)row * DM, lane);
#pragma unroll
            for (int j = 0; j < 4; ++j) v[j] = vn[j];
        }
    }
    if (nsplit > 0) for (int row = RL + gw; row < nrows; row += NGW) {
        f32x4 v[4];
        const float* xr = xC + (size_t)(row - RL) * DM;
#pragma unroll
        for (int j = 0; j < 4; ++j) v[j] = *(const f32x4*)(xr + 4 * lane + 256 * j);
#pragma unroll
        for (int j = 0; j < 4; ++j) {
            f32x4 pv[11];
#pragma unroll
            for (int ks = 0; ks < 11; ++ks) if (ks < nsplit) pv[ks] = *(const f32x4*)(part + ((size_t)ks * RC + (row - RL)) * DM + 4 * lane + 256 * j);
            f32x4 sum = {0.f, 0.f, 0.f, 0.f};
#pragma unroll
            for (int ks = 0; ks < 11; ++ks) if (ks < nsplit) sum += pv[ks];
            v[j] += sum * (*(const f32x4*)(pgate + 4 * lane + 256 * j) * pscale);
            *(f32x4*)(xCw + (size_t)(row - RL) * DM + 4 * lane + 256 * j) = v[j];
        }
        norm_row(v, gn, modl + (size_t)4 * 9216 + ishift * 1024, H + (size_t)row * DM, lane);
    }
}
__device__ __forceinline__ void final_phase(const float* x, const float* gain, float* out) {
    const int tid_ = opaque_tid(); const int lane = tid_ & 63, wave = __builtin_amdgcn_readfirstlane(tid_ >> 6);
    const int gw = blockIdx.x * NWAVES + wave, NGW = gridDim.x * NWAVES;
    f32x4 gn[4];
#pragma unroll
    for (int j = 0; j < 4; ++j) gn[j] = *(const f32x4*)(gain + 4 * lane + 256 * j);
    int row = gw; f32x4 v[4], vn[4];
    if (row < RL) {
#pragma unroll
        for (int j = 0; j < 4; ++j) v[j] = *(const f32x4*)(x + (size_t)row * DM + 4 * lane + 256 * j); }
    for (; row < RL; row += NGW) {
        const int rn = row + NGW;
        if (rn < RL) {
#pragma unroll
            for (int j = 0; j < 4; ++j) vn[j] = *(const f32x4*)(x + (size_t)rn * DM + 4 * lane + 256 * j); }
        float ss = 0.f;
#pragma unroll
        for (int j = 0; j < 4; ++j) ss += (v[j][0] * v[j][0] + v[j][1] * v[j][1]) + (v[j][2] * v[j][2] + v[j][3] * v[j][3]);
        const float rstd = __builtin_amdgcn_rsqf(wave_sum(ss) * (1.0f / DM) + EPS);
#pragma unroll
        for (int j = 0; j < 4; ++j) *(f32x4*)(out + (size_t)row * DM + 4 * lane + 256 * j) = v[j] * rstd * gn[j];
#pragma unroll
        for (int j = 0; j < 4; ++j) v[j] = vn[j];
    }
}

__device__ __forceinline__ int pi16(int t) { return (t & ~12) | ((t & 8) >> 1) | ((t & 4) << 1); }
template <int NS, int DQK, int DV, bool KSH  >
__device__ __forceinline__ void attn_unit(LAS unsigned char* lds, const bf16_t* Qh0, const bf16_t* Kh0, const int sstride  , const bf16_t* Vt  ,
                                          int qrow0, int bidx, int tlo, int thi, bf16_t* Y  , float lam, const float* gsub, float outscale) {
    constexpr int CK = DQK / 8, KS = DQK / 16, NDB = DV / 32;
    constexpr int NKS = KSH ? 1 : NS;
    constexpr int KBYTES = NKS * CK * 1024, VBYTES = 8 * DV * 16, BUFB = KBYTES + VBYTES;
    constexpr int NKW = NKS * CK, NVP = DV * 8;
    constexpr int NKL = (NKW + NWAVES - 1) / NWAVES, NVL = (NVP + NTHREADS - 1) / NTHREADS;
    const int tid = opaque_tid(), lane = tid & 63, r32 = lane & 31, hi = lane >> 5; const int wid = __builtin_amdgcn_readfirstlane(tid >> 6);
    LAS float* wsf = (LAS float*)(lds + 3 * BUFB) + wid * 64;
    int kg[NKL]; int vg[NVL];
#pragma unroll
    for (int i = 0; i < NKL; ++i) { const int cck = wid + i * NWAVES; const int c2 = cck < NKW ? cck : 0; const int c = c2 / CK, ck = c2 % CK; kg[i] = c * sstride + pi16(lane) * DQK + ck * 8; }
#pragma unroll
    for (int i = 0; i < NVL; ++i) { const int idx = tid + i * NTHREADS; const int id2 = idx < NVP ? idx : 0; const int c8 = id2 / DV, d = id2 % DV; vg[i] = d * R + c8 * 8; }
    auto tokbase = [&](int t) -> int { return t < 128 ? bidx * SEQ + 64 * t : RL + bidx * CTXL + 64 * (t - 128); };
#define ATT_DMA(T, BOFF) do { const int tb_ = tokbase(T); \
        _Pragma("unroll") for (int i_ = 0; i_ < NKL; ++i_) if (wid + i_ * NWAVES < NKW) \
            __builtin_amdgcn_global_load_lds((const unsigned*)(Kh0 + (kg[i_] + tb_ * DQK)), (LAS unsigned*)(lds + (BOFF) + (wid + i_ * NWAVES) * 1024), 16, 0, 0); \
        _Pragma("unroll") for (int i_ = 0; i_ < NVL; ++i_) if (wid * 64 + i_ * NTHREADS < NVP) \
            __builtin_amdgcn_global_load_lds((const unsigned*)(Vt + (vg[i_] + tb_)), (LAS unsigned*)(lds + (BOFF) + KBYTES + (wid * 64 + i_ * NTHREADS) * 16), 16, 0, 0); } while (0)
#define ATT_SYNC() do { asm volatile("s_waitcnt vmcnt(0)" ::: "memory"); __syncthreads(); } while (0)
    constexpr bool QLDS = (NS > 1);
    LAS unsigned char* qlds = lds + 3 * BUFB + 2048 + wid * 1024 + lane * 16;
    bf16x8 qr[QLDS ? 1 : NS][QLDS ? 1 : KS];
#pragma unroll
    for (int c = 0; c < NS; ++c)
#pragma unroll
        for (int d0 = 0; d0 < KS; ++d0) {
            const bf16x8 qv = *(const bf16x8*)(Qh0 + (size_t)c * sstride + (size_t)(qrow0 + wid * 32 + r32) * DQK + d0 * 16 + hi * 8);
            if constexpr (QLDS) *(LAS bf16x8*)(qlds + (c * KS + d0) * 8192) = qv; else qr[c][d0] = qv;
        }
    f32x16 o[NS][NDB];
#pragma unroll
    for (int c = 0; c < NS; ++c)
#pragma unroll
        for (int d = 0; d < NDB; ++d)
#pragma unroll
            for (int r = 0; r < 16; ++r) o[c][d][r] = 0.f;
    float mrun[NS], lrun[NS];
#pragma unroll
    for (int c = 0; c < NS; ++c) { mrun[c] = 0.f; lrun[c] = 0.f; }
    f32x16 pA0, pA1, pB0, pB1;
    bf16x8 pa0, pa1, pa2, pa3;
#define ATT_QK(P0, P1, C, BOFF) do { \
        _Pragma("unroll") for (int r_ = 0; r_ < 16; ++r_) { P0[r_] = -mrun[C]; P1[r_] = -mrun[C]; } \
        const LAS unsigned char* kb_ = lds + (BOFF) + (KSH ? 0 : (C)) * CK * 1024 + hi * 1024 + r32 * 16; \
        int zo_ = 0; asm volatile("" : "+v"(zo_));     \
        _Pragma("unroll") for (int d0_ = 0; d0_ < KS; ++d0_) { \
            const bf16x8 ka_ = *(const LAS bf16x8*)(kb_ + d0_ * 2048), kc_ = *(const LAS bf16x8*)(kb_ + d0_ * 2048 + 512); \
            bf16x8 qf_; if constexpr (QLDS) qf_ = *(const LAS bf16x8*)(qlds + zo_ + ((C) * KS + d0_) * 8192); else qf_ = qr[QLDS ? 0 : (C)][QLDS ? 0 : d0_]; \
            P0 = __builtin_amdgcn_mfma_f32_32x32x16_bf16(ka_, qf_, P0, 0, 0, 0); \
            P1 = __builtin_amdgcn_mfma_f32_32x32x16_bf16(kc_, qf_, P1, 0, 0, 0); } } while (0)
#define ATT_MAX(P0, P1, C, FIRST) do { \
        float rm_ = max3f(P0[0], P1[0], P0[1]), rn_ = max3f(P1[1], P0[2], P1[2]); \
        _Pragma("unroll") for (int r_ = 3; r_ < 15; r_ += 2) { rm_ = max3f(rm_, P0[r_], P1[r_]); rn_ = max3f(rn_, P0[r_ + 1], P1[r_ + 1]); } \
        rm_ = max3f(rm_, P0[15], P1[15]); rm_ = max3f(rm_, rn_, rn_); \
        rm_ = xmax32(rm_); \
        const bool first_ = (FIRST); \
        if (first_ || __any(rm_ > 8.0f)) { \
            const float dl_ = first_ ? rm_ : fmaxf(rm_, 0.f); \
            mrun[C] += dl_; \
            _Pragma("unroll") for (int r_ = 0; r_ < 16; ++r_) { P0[r_] -= dl_; P1[r_] -= dl_; } \
            if (!first_) { \
                const float f_ = fast_exp2(-dl_); lrun[C] *= f_; \
                if (hi == 0) wsf[r32] = f_; \
                asm volatile("s_waitcnt lgkmcnt(0)" ::: "memory"); \
                _Pragma("unroll") for (int r_ = 0; r_ < 16; ++r_) { const float fr_ = wsf[crow(r_, hi)]; \
                    _Pragma("unroll") for (int d_ = 0; d_ < NDB; ++d_) o[C][d_][r_] *= fr_; } \
                asm volatile("s_waitcnt lgkmcnt(0)" ::: "memory"); \
            } } } while (0)
#define ATT_EXP(P0, P1, C) do { \
        float ls_ = 0.f; \
        _Pragma("unroll") for (int r_ = 0; r_ < 16; ++r_) { P0[r_] = fast_exp2(P0[r_]); P1[r_] = fast_exp2(P1[r_]); ls_ += P0[r_] + P1[r_]; } \
        lrun[C] += ls_; \
        u32x4 w0_, w1_, w2_, w3_; \
        w0_.x = cvt_pk_bf16(P0[0], P0[1]); w0_.y = cvt_pk_bf16(P0[2], P0[3]); w0_.z = cvt_pk_bf16(P0[4], P0[5]); w0_.w = cvt_pk_bf16(P0[6], P0[7]); \
        w1_.x = cvt_pk_bf16(P0[8], P0[9]); w1_.y = cvt_pk_bf16(P0[10], P0[11]); w1_.z = cvt_pk_bf16(P0[12], P0[13]); w1_.w = cvt_pk_bf16(P0[14], P0[15]); \
        w2_.x = cvt_pk_bf16(P1[0], P1[1]); w2_.y = cvt_pk_bf16(P1[2], P1[3]); w2_.z = cvt_pk_bf16(P1[4], P1[5]); w2_.w = cvt_pk_bf16(P1[6], P1[7]); \
        w3_.x = cvt_pk_bf16(P1[8], P1[9]); w3_.y = cvt_pk_bf16(P1[10], P1[11]); w3_.z = cvt_pk_bf16(P1[12], P1[13]); w3_.w = cvt_pk_bf16(P1[14], P1[15]); \
        pa0 = __builtin_bit_cast(bf16x8, w0_); pa1 = __builtin_bit_cast(bf16x8, w1_); pa2 = __builtin_bit_cast(bf16x8, w2_); pa3 = __builtin_bit_cast(bf16x8, w3_); } while (0)
#define ATT_QKEXP(PN0, PN1, CN, BOFF, PC0, PC1, CC) do { \
        __builtin_amdgcn_iglp_opt(1); \
        _Pragma("unroll") for (int r_ = 0; r_ < 16; ++r_) { PN0[r_] = -mrun[CN]; PN1[r_] = -mrun[CN]; } \
        const LAS unsigned char* kb_ = lds + (BOFF) + (KSH ? 0 : (CN)) * CK * 1024 + hi * 1024 + r32 * 16; \
        float ls_ = 0.f; unsigned w_[16]; \
        _Pragma("unroll") for (int d0_ = 0; d0_ < KS; ++d0_) { \
            int zo_ = 0; asm volatile("" : "+v"(zo_)); \
            const bf16x8 ka_ = *(const LAS bf16x8*)(kb_ + zo_ + d0_ * 2048), kc_ = *(const LAS bf16x8*)(kb_ + zo_ + d0_ * 2048 + 512); \
            bf16x8 qf_; if constexpr (QLDS) qf_ = *(const LAS bf16x8*)(qlds + zo_ + ((CN) * KS + d0_) * 8192); else qf_ = qr[QLDS ? 0 : (CN)][QLDS ? 0 : d0_]; \
            PN0 = __builtin_amdgcn_mfma_f32_32x32x16_bf16(ka_, qf_, PN0, 0, 0, 0); \
            PN1 = __builtin_amdgcn_mfma_f32_32x32x16_bf16(kc_, qf_, PN1, 0, 0, 0); \
            _Pragma("unroll") for (int r_ = ((16 * d0_ / KS) & ~1); r_ < (d0_ == KS - 1 ? 16 : ((16 * (d0_ + 1) / KS) & ~1)); r_ += 2) { \
                PC0[r_] = fast_exp2(PC0[r_]); PC0[r_ + 1] = fast_exp2(PC0[r_ + 1]); PC1[r_] = fast_exp2(PC1[r_]); PC1[r_ + 1] = fast_exp2(PC1[r_ + 1]); \
                ls_ += (PC0[r_] + PC0[r_ + 1]) + (PC1[r_] + PC1[r_ + 1]); \
                w_[r_ >> 1] = cvt_pk_bf16(PC0[r_], PC0[r_ + 1]); w_[8 + (r_ >> 1)] = cvt_pk_bf16(PC1[r_], PC1[r_ + 1]); } } \
        lrun[CC] += ls_; \
        pa0 = __builtin_bit_cast(bf16x8, (u32x4){w_[0], w_[1], w_[2], w_[3]}); pa1 = __builtin_bit_cast(bf16x8, (u32x4){w_[4], w_[5], w_[6], w_[7]}); \
        pa2 = __builtin_bit_cast(bf16x8, (u32x4){w_[8], w_[9], w_[10], w_[11]}); pa3 = __builtin_bit_cast(bf16x8, (u32x4){w_[12], w_[13], w_[14], w_[15]}); } while (0)
#define ATT_PV(C, BOFF) do { \
        const LAS unsigned char* vb_ = lds + (BOFF) + KBYTES + hi * DV * 16 + r32 * 16; \
        _Pragma("unroll") for (int d_ = 0; d_ < NDB; ++d_) { \
            o[C][d_] = __builtin_amdgcn_mfma_f32_32x32x16_bf16(pa0, *(const LAS bf16x8*)(vb_ + 0 * DV * 16 + d_ * 512), o[C][d_], 0, 0, 0); \
            o[C][d_] = __builtin_amdgcn_mfma_f32_32x32x16_bf16(pa1, *(const LAS bf16x8*)(vb_ + 2 * DV * 16 + d_ * 512), o[C][d_], 0, 0, 0); \
            o[C][d_] = __builtin_amdgcn_mfma_f32_32x32x16_bf16(pa2, *(const LAS bf16x8*)(vb_ + 4 * DV * 16 + d_ * 512), o[C][d_], 0, 0, 0); \
            o[C][d_] = __builtin_amdgcn_mfma_f32_32x32x16_bf16(pa3, *(const LAS bf16x8*)(vb_ + 6 * DV * 16 + d_ * 512), o[C][d_], 0, 0, 0); } } while (0)
    ATT_DMA(tlo, 0); ATT_DMA(tlo + 1, BUFB);
    ATT_SYNC();
    int bc = 0, bn = BUFB, bnn = 2 * BUFB;
    ATT_QK(pA0, pA1, 0, bc);
    if constexpr (NS == 1) {
        for (int t = tlo; t < thi; t += 2) {
            if (t + 2 < thi) ATT_DMA(t + 2, bnn);
            ATT_MAX(pA0, pA1, 0, t == tlo);
            ATT_QKEXP(pB0, pB1, 0, bn, pA0, pA1, 0);
            ATT_PV(0, bc);
            ATT_SYNC();
            if (t + 3 < thi) ATT_DMA(t + 3, bc);
            ATT_MAX(pB0, pB1, 0, false);
            ATT_QKEXP(pA0, pA1, 0, bnn, pB0, pB1, 0);
            ATT_PV(0, bn);
            ATT_SYNC();
            const int tmp = bc; bc = bnn; bnn = bn; bn = tmp;
        }
    } else if constexpr (NS == 3) {
        for (int t = tlo; t < thi; t += 2) {
            const bool first = (t == tlo);
            if (t + 2 < thi) ATT_DMA(t + 2, bnn);
            ATT_MAX(pA0, pA1, 0, first); ATT_QKEXP(pB0, pB1, 1, bc, pA0, pA1, 0); ATT_PV(0, bc);
            ATT_MAX(pB0, pB1, 1, first); ATT_QKEXP(pA0, pA1, NS - 1, bc, pB0, pB1, 1); ATT_PV(1, bc);
            ATT_MAX(pA0, pA1, NS - 1, first); ATT_QKEXP(pB0, pB1, 0, bn, pA0, pA1, NS - 1); ATT_PV(NS - 1, bc);
            ATT_SYNC();
            if (t + 3 < thi) ATT_DMA(t + 3, bc);
            ATT_MAX(pB0, pB1, 0, false); ATT_QKEXP(pA0, pA1, 1, bn, pB0, pB1, 0); ATT_PV(0, bn);
            ATT_MAX(pA0, pA1, 1, false); ATT_QKEXP(pB0, pB1, NS - 1, bn, pA0, pA1, 1); ATT_PV(1, bn);
            ATT_MAX(pB0, pB1, NS - 1, false); ATT_QKEXP(pA0, pA1, 0, bnn, pB0, pB1, NS - 1); ATT_PV(NS - 1, bn);
            ATT_SYNC();
            const int tmp = bc; bc = bnn; bnn = bn; bn = tmp;
        }
    } else {
        for (int t = tlo; t < thi; ++t) {
            if (t + 2 < thi) ATT_DMA(t + 2, bnn);
            ATT_MAX(pA0, pA1, 0, t == tlo);
            ATT_QKEXP(pB0, pB1, NS - 1, bc, pA0, pA1, 0);
            ATT_PV(0, bc);
            ATT_MAX(pB0, pB1, NS - 1, t == tlo);
            ATT_QKEXP(pA0, pA1, 0, bn, pB0, pB1, NS - 1);
            ATT_PV(NS - 1, bc);
            ATT_SYNC();
            const int tmp = bc; bc = bn; bn = bnn; bnn = tmp;
        }
    }
#undef ATT_DMA
#undef ATT_SYNC
#undef ATT_QK
#undef ATT_MAX
#undef ATT_EXP
#undef ATT_PV
#undef ATT_QKEXP
    float rl[NS][16];
#pragma unroll
    for (int c = 0; c < NS; ++c) {
        const float lt = xadd32(lrun[c]);
        if (hi == 0) wsf[r32] = fast_rcp(lt);
        asm volatile("s_waitcnt lgkmcnt(0)" ::: "memory");
#pragma unroll
        for (int r = 0; r < 16; ++r) rl[c][r] = wsf[crow(r, hi)];
        asm volatile("s_waitcnt lgkmcnt(0)" ::: "memory");
    }
    constexpr int NOUT = KSH ? NS * DV : DV;
    LAS bf16_t* stg = (LAS bf16_t*)(lds + (QLDS ? 3 * BUFB + 2048 : 0) + wid * (32 * NOUT * 2));
    if constexpr (KSH) {
#pragma unroll
        for (int c = 0; c < NS; ++c)
#pragma unroll
        for (int d = 0; d < NDB; ++d)
#pragma unroll
            for (int r = 0; r < 16; ++r) {
                const float v = o[c][d][r] * rl[c][r];
                stg[crow(r, hi) * NOUT + c * DV + d * 32 + r32] = (bf16_t)(cvt_pk_bf16(v, 0.f) & 0xffffu);
            }
    } else {
        float ss[16];
#pragma unroll
        for (int r = 0; r < 16; ++r) ss[r] = 0.f;
#pragma unroll
        for (int d = 0; d < NDB; ++d)
#pragma unroll
            for (int r = 0; r < 16; ++r) { const float v = o[0][d][r] * rl[0][r] - lam * (o[1][d][r] * rl[1][r]); o[0][d][r] = v; ss[r] += v * v; }
#pragma unroll
        for (int r = 0; r < 16; ++r) {
            ss[r] = sum32(ss[r]);
            ss[r] = __builtin_amdgcn_rsqf(ss[r] * (1.0f / DV) + EPS) * outscale;
        }
#pragma unroll
        for (int d = 0; d < NDB; ++d) {
            const float g = gsub[d * 32 + r32];
#pragma unroll
            for (int r = 0; r < 16; ++r) {
                const float v = o[0][d][r] * ss[r] * g;
                stg[crow(r, hi) * NOUT + d * 32 + r32] = (bf16_t)(cvt_pk_bf16(v, 0.f) & 0xffffu);
            }
        }
    }
    asm volatile("s_waitcnt lgkmcnt(0)" ::: "memory");
    {
        constexpr int CPR = NOUT / 8;
        constexpr int NIT = 32 * CPR / 64;
#pragma unroll
        for (int i = 0; i < NIT; ++i) {
            const int idx = i * 64 + lane; const int row = idx / CPR, ch = idx % CPR;
            const u32x4 v = *(const LAS u32x4*)(stg + row * NOUT + ch * 8);
            *(u32x4*)(Y + (size_t)(qrow0 + wid * 32 + row) * DM + ch * 8) = v;
        }
    }
}

__device__ __forceinline__ void bmix_unit(LAS unsigned char* lds, const bf16_t* U, const bf16_t* VG, const float* gv  , const float* ws  , const float* bs  ,
                                          int ci, int g, bf16_t* Y) {
    const int tid = opaque_tid(), lane = tid & 63, r32 = lane & 31, hi = lane >> 5; const int wid = __builtin_amdgcn_readfirstlane(tid >> 6);
    const int r0 = ci * 128;
    LAS float* rstd = (LAS float*)lds;
    LAS bf16_t* vnT = (LAS bf16_t*)(lds + 512);
    {
        const int q = tid >> 2, part = tid & 3; float ss = 0.f;
        const bf16_t* p = VG + (size_t)(r0 + q) * 256 + part * 64;
#pragma unroll
        for (int i = 0; i < 8; ++i) { const u32x4 w = *(const u32x4*)(p + 8 * i);
#pragma unroll
            for (int e = 0; e < 4; ++e) { const float lo = __uint_as_float(w[e] << 16), hi2 = __uint_as_float(w[e] & 0xffff0000u); ss += lo * lo + hi2 * hi2; } }
        ss += swz_xor<1>(ss); ss += swz_xor<2>(ss);
        if (part == 0) rstd[q] = __builtin_amdgcn_rsqf(ss * (1.0f / 256.0f) + EPS);
    }
    __syncthreads();
#pragma unroll
    for (int i = 0; i < 2; ++i) {
        const int idx = tid + i * NTHREADS; const int q = idx >> 3, c8 = idx & 7;
        const u32x4 w = *(const u32x4*)(VG + (size_t)(r0 + q) * 256 + g * 64 + c8 * 8); const float rs = rstd[q];
#pragma unroll
        for (int e = 0; e < 4; ++e) {
            const float lo = __uint_as_float(w[e] << 16) * rs * gv[g * 64 + c8 * 8 + 2 * e], hi2 = __uint_as_float(w[e] & 0xffff0000u) * rs * gv[g * 64 + c8 * 8 + 2 * e + 1];
            const unsigned pk = cvt_pk_bf16(lo, hi2);
            vnT[(c8 * 8 + 2 * e) * 136 + q] = (bf16_t)(pk & 0xffffu); vnT[(c8 * 8 + 2 * e + 1) * 136 + q] = (bf16_t)(pk >> 16);
        }
    }
    __syncthreads();
    const int pblk = wid & 3, cblk = wid >> 2;
    f32x16 acc;
#pragma unroll
    for (int r = 0; r < 16; ++r) acc[r] = 0.f;
    const float* wrow = ws + ((size_t)g * 128 + pblk * 32 + r32) * 128 + hi * 8;
#pragma unroll
    for (int ks = 0; ks < 8; ++ks) {
        const f32x4 a0 = *(const f32x4*)(wrow + ks * 16), a1 = *(const f32x4*)(wrow + ks * 16 + 4);
        u32x4 aw; aw.x = cvt_pk_bf16(a0[0], a0[1]); aw.y = cvt_pk_bf16(a0[2], a0[3]); aw.z = cvt_pk_bf16(a1[0], a1[1]); aw.w = cvt_pk_bf16(a1[2], a1[3]);
        const bf16x8 bfr = *(const LAS bf16x8*)(vnT + (cblk * 32 + r32) * 136 + ks * 16 + hi * 8);
        acc = __builtin_amdgcn_mfma_f32_32x32x16_bf16(__builtin_bit_cast(bf16x8, aw), bfr, acc, 0, 0, 0);
    }
#pragma unroll
    for (int r = 0; r < 16; ++r) {
        const int p = pblk * 32 + crow(r, hi); const int col = g * 64 + cblk * 32 + r32;
        const float mixed = acc[r] + bs[g * 128 + p];
        const float uu = bf2f(U[(size_t)(r0 + p) * 256 + col]);
        Y[(size_t)(r0 + p) * DM + 384 + col] = (bf16_t)(cvt_pk_bf16(uu * mixed, 0.f) & 0xffffu);
    }
    __syncthreads();
}

__device__ __forceinline__ void mixer_phase(const Args& a, LAS unsigned char* lds, int l, unsigned* ctr) {
    const bool last = (l == DEPTH - 1);
    unsigned char* mx = a.ws + WS_ACT;
    bf16_t* Y = (bf16_t*)(a.ws + WS_H);
    const bf16_t* QA = (const bf16_t*)(mx + MX_QA); const bf16_t* KA = (const bf16_t*)(mx + MX_KA);
    const bf16_t* QC = (const bf16_t*)(mx + MX_QC); const bf16_t* KC = (const bf16_t*)(mx + MX_KC);
    const bf16_t* VT = (const bf16_t*)(mx + MX_VT);
    const int nC = 512, nA = 512, nCc = last ? 0 : 16, nAc = last ? 0 : 16, nB = last ? 1024 : 1056;
    const int total = nC + nA + nCc + nAc + nB;
    const float* lv = a.in[I_LAM] + l * 4 * 48;
    float d1 = 0.f, d2 = 0.f;
    for (int i = 0; i < 48; ++i) { d1 += lv[i] * lv[48 + i]; d2 += lv[96 + i] * lv[144 + i]; }
    const float lam_init = 0.8f - 0.6f * expf(-0.3f * (float)l);
    const float lam = expf(d1) - expf(d2) + lam_init;
    LAS unsigned* sidx = (LAS unsigned*)(lds + LDS_MISC + 64);
    const int nBx = nB >> 3, nCx = last ? 0 : 4, tq = 128 + nCx + nBx;
    int myq = (int)(xb_xcc_id() & 7u), ndead = 0;
    for (;;) {
        if (opaque_tid() == 0) {
            unsigned v = 0xffffffffu;
            while (ndead < 8) { const unsigned w = atomicAdd(ctr + 64 * myq, 1u); if (w < (unsigned)tq) { v = w; break; } myq = (myq + 1) & 7; ++ndead; }
            unsigned g = 0xffffffffu;
            if (v != 0xffffffffu) { const int q = myq; int j = (int)v;
                if (j < 64) g = (unsigned)((2 * q + (j >> 5)) * 32 + (j & 31));
                else if (j < 96) g = (unsigned)(nC + q * 32 + (j - 64));
                else if (j < 128) g = (unsigned)(nC + 256 + q * 32 + (j - 96));
                else { j -= 128;
                    if (j < nCx) { if (j < 2) g = (unsigned)(nC + nA + 2 * q + j); else if (j == 2) g = (unsigned)(nC + nA + nCc + q); else g = (unsigned)(nC + nA + nCc + 8 + q); }
                    else g = (unsigned)(nC + nA + nCc + nAc + q * nBx + (j - nCx)); } }
            *sidx = g;
        }
        __syncthreads();
        const int idx = (int)*sidx;
        __syncthreads();
        if (idx < 0 || idx >= total) break;
        int j = idx;
        if (j < nC) {
            const int b = j >> 7, h = (j >> 5) & 3, qb = j & 31;
            attn_unit<2, 48, 96, false>(lds, QC + (size_t)h * R * 48, KC + (size_t)h * R * 48, 4 * R * 48, VT + (size_t)(128 + h * 96) * R, b * SEQ + qb * 256, b, 0, 132, Y + 640 + h * 96, lam, a.in[I_GSUB] + l * 96, 1.0f - lam_init);
            continue;
        }
        j -= nC;
        if (j < nA) {
            const int pair = j < 256; const int jj = j & 255; const int b = jj >> 6, hkv = (jj >> 5) & 1, qb = jj & 31;
            if (pair) attn_unit<2, 64, 64, true>(lds, QA + (size_t)(hkv * 3) * R * 64, KA + (size_t)hkv * R * 64, R * 64, VT + (size_t)(hkv * 64) * R, b * SEQ + qb * 256, b, 0, 132, Y + hkv * 192, 0.f, nullptr, 1.0f);
            else attn_unit<1, 64, 64, true>(lds, QA + (size_t)(hkv * 3 + 2) * R * 64, KA + (size_t)hkv * R * 64, 0, VT + (size_t)(hkv * 64) * R, b * SEQ + qb * 256, b, 0, 132, Y + hkv * 192 + 128, 0.f, nullptr, 1.0f);
            continue;
        }
        j -= nA;
        if (j < nCc) {
            const int b = j >> 2, h = j & 3;
            attn_unit<2, 48, 96, false>(lds, QC + (size_t)h * R * 48, KC + (size_t)h * R * 48, 4 * R * 48, VT + (size_t)(128 + h * 96) * R, RL + b * CTXL, b, 128, 132, Y + 640 + h * 96, lam, a.in[I_GSUB] + l * 96, 1.0f - lam_init);
            continue;
        }
        j -= nCc;
        if (j < nAc) {
            const int pair = j < 8; const int jj = j & 7; const int b = jj >> 1, hkv = jj & 1;
            if (pair) attn_unit<2, 64, 64, true>(lds, QA + (size_t)(hkv * 3) * R * 64, KA + (size_t)hkv * R * 64, R * 64, VT + (size_t)(hkv * 64) * R, RL + b * CTXL, b, 128, 132, Y + hkv * 192, 0.f, nullptr, 1.0f);
            else attn_unit<1, 64, 64, true>(lds, QA + (size_t)(hkv * 3 + 2) * R * 64, KA + (size_t)hkv * R * 64, 0, VT + (size_t)(hkv * 64) * R, RL + b * CTXL, b, 128, 132, Y + hkv * 192 + 128, 0.f, nullptr, 1.0f);
            continue;
        }
        j -= nAc;
        bmix_unit(lds, (const bf16_t*)(mx + MX_U), (const bf16_t*)(mx + MX_VG), a.in[I_GV] + l * 256, a.in[I_WS] + (size_t)l * 4 * 128 * 128, a.in[I_BS] + l * 4 * 128, j >> 2, j & 3, Y);
    }
}

__global__ void __launch_bounds__(NTHREADS, 2) fwd_megakernel(Args a) {
    extern __shared__ __attribute__((aligned(16))) unsigned char lds_raw[];
    LAS unsigned char* lds = (LAS unsigned char*)lds_raw;
    const int tid = threadIdx.x, lane = tid & 63; const int wave = __builtin_amdgcn_readfirstlane(tid >> 6);
    const int G = gridDim.x, bx = blockIdx.x;
    volatile LAS unsigned* MISC = (volatile LAS unsigned*)(lds + LDS_MISC);
    if (tid < 64) MISC[tid] = 0u;
    __syncthreads();
    unsigned* ctl = (unsigned*)(a.ws + WS_CTL);
    XcdBarrier bar = xcd_barrier_post(ctl + 4096, MISC + 8);
    unsigned* qctr = ctl + 16384;

    phase0(a, lds, tid, lane, wave);
    cg::this_grid().sync();

    float* xres = (float*)(a.ws + WS_XRES);
    bf16_t* H = (bf16_t*)(a.ws + WS_H);
    bf16_t* ACT = (bf16_t*)(a.ws + WS_ACT);
    const float* modv = (const float*)(a.ws + WS_MODV);
    float* part = (float*)(a.ws + WS_PART);
#pragma unroll 1
    for (int l = 0; l < DEPTH; ++l) {
        const bool last = (l == DEPTH - 1);
        const float* modl = modv + (size_t)l * 5 * 9216;
        unsigned char* wl = a.ws + WS_W + (size_t)l * LAYER_W_BYTES;
        const float* xL = (l == 0) ? a.in[I_X] : xres;
        const float* xC = (l == 0) ? a.in[I_CTX] : xres + (size_t)RL * DM;
        norm_phase(xL, xC, a.in[I_GFFN1] + l * DM, modl, 0, H, R, part, l == 0 ? 0 : 11, modl - 5 * 9216 + 4 * 9216 + 8 * 1024, 0.5f, xres + (size_t)RL * DM);
        xcd_barrier(bar);
        { pg8::SchedOne S{(const char*)H, (const char*)(wl + W_1IN), 132, 22, G, bx, (size_t)256 * 1024 * 2, 16}; pg8::EpiUp E{ACT};
          pg8::gemm_phase<pg8::EpiUp, pg8::SchedOne>(lds, 1024, S, E); }
        xcd_barrier(bar);
        { pg8::SchedDown S{(const char*)ACT, (const char*)(wl + W_1OUT), G, bx, (size_t)256 * FF * 2, 44, 4, 11, 4}; pg8::EpiDown E{xL, xres + (size_t)RL * DM, xres, modl + 2 * 1024, 0.5f, part};
          pg8::gemm_phase<pg8::EpiDown, pg8::SchedDown>(lds, FF, S, E); }
        xcd_barrier(bar);
        norm_phase(xres, xres + (size_t)RL * DM, a.in[I_GMIX] + l * DM, modl, 3, H, R, part, 11, modl + 4 * 9216 + 2 * 1024, 0.5f, xres + (size_t)RL * DM);
        xcd_barrier(bar);
        { pg8::SchedMix S{(const char*)H, (const char*)(wl + W_MIX), (const char*)(wl + W_MIX) + (size_t)1792 * 1024 * 2, G, bx, (size_t)256 * 1024 * 2};
          pg8::EpiMix E{a.ws + WS_ACT, (const float*)(a.ws + WS_GTAB) + l * 128, (const float*)(a.ws + WS_GTAB) + l * 128 + 64};
          pg8::gemm_phase<pg8::EpiMix, pg8::SchedMix>(lds, 1024, S, E); }
        xcd_barrier(bar);
        mixer_phase(a, lds, l, qctr + 64 * 8 * l);
        xcd_barrier(bar);
        { pg8::SchedDown S{(const char*)H, (const char*)(wl + W_OUT), G, bx, (size_t)256 * 1024 * 2, 16, last ? 0 : 4, 4, 4}; pg8::EpiDown E{xres, xres + (size_t)RL * DM, xres, modl + 5 * 1024, 1.0f, part};
          pg8::gemm_phase<pg8::EpiDown, pg8::SchedDown>(lds, 1024, S, E); }
        xcd_barrier(bar);
        norm_phase(xres, xres + (size_t)RL * DM, a.in[I_GFFN2] + l * DM, modl, 6, H, last ? RL : R, part, 4, modl + 4 * 9216 + 5 * 1024, 1.0f, xres + (size_t)RL * DM);
        xcd_barrier(bar);
        { pg8::SchedOne S{(const char*)H, (const char*)(wl + W_2IN), last ? 128 : 132, 22, G, bx, (size_t)256 * 1024 * 2, 16}; pg8::EpiUp E{ACT};
          pg8::gemm_phase<pg8::EpiUp, pg8::SchedOne>(lds, 1024, S, E); }
        xcd_barrier(bar);
        { pg8::SchedDown S{(const char*)ACT, (const char*)(wl + W_2OUT), G, bx, (size_t)256 * FF * 2, 44, last ? 0 : 4, 11, 4}; pg8::EpiDown E{xres, xres + (size_t)RL * DM, xres, modl + 8 * 1024, 0.5f, part};
          pg8::gemm_phase<pg8::EpiDown, pg8::SchedDown>(lds, FF, S, E); }
        xcd_barrier(bar);
    }
    final_phase(xres, a.in[I_GFINAL], a.out);
}

extern "C" void kernel_launch(void* const* d_in, const int* in_sizes, int n_in, void* d_out, int out_size, void* d_ws, size_t ws_size, hipStream_t stream) {
    static int grid = 0;
    if (grid == 0) {
        if (n_in != 23 || ws_size < WS_END) { fprintf(stderr, "kernel_launch: n_in %d ws %zu (need %zu)\n", n_in, ws_size, (size_t)WS_END); grid = -1; return; }
        int dev = 0, cus = 0, per_cu = 0;
        hipGetDevice(&dev); hipDeviceGetAttribute(&cus, hipDeviceAttributeMultiprocessorCount, dev);
        hipFuncSetAttribute((const void*)fwd_megakernel, hipFuncAttributeMaxDynamicSharedMemorySize, LDS_BYTES);
        hipOccupancyMaxActiveBlocksPerMultiprocessor(&per_cu, (const void*)fwd_megakernel, NTHREADS, LDS_BYTES);
        (void)hipGetLastError();
        if (per_cu < 1) { fprintf(stderr, "kernel_launch: occupancy query says %d blocks per CU\n", per_cu); per_cu = 1; }
        grid = cus;
    }
    if (grid < 0) return;
    hipMemsetAsync((char*)d_ws + WS_CTL, 0, 1 * MiB, stream);
    Args a{};
    for (int i = 0; i < 23; ++i) a.in[i] = (const float*)d_in[i];
    a.out = (float*)d_out; a.ws = (unsigned char*)d_ws;
    void* args[] = {&a};
    hipError_t e = hipLaunchCooperativeKernel((const void*)fwd_megakernel, dim3(grid), dim3(NTHREADS), args, LDS_BYTES, stream);
    if (e != hipSuccess) fprintf(stderr, "cooperative launch failed: %s (grid %d)\n", hipGetErrorString(e), grid);
}
```

```cpp
#include <hip/hip_runtime.h>
#include <hip/hip_cooperative_groups.h>
#include <cstdio>
#include <cstdint>
namespace cg = cooperative_groups;

#define LAS __attribute__((address_space(3)))
typedef unsigned short bf16_t;
typedef short bf16x8 __attribute__((ext_vector_type(8)));
typedef float f32x4 __attribute__((ext_vector_type(4)));
typedef float f32x2 __attribute__((ext_vector_type(2)));
typedef float f32x16 __attribute__((ext_vector_type(16)));
typedef unsigned u32x4 __attribute__((ext_vector_type(4)));
typedef unsigned u32x2 __attribute__((ext_vector_type(2)));

constexpr int DM = 1024, NB = 4, SEQ = 8192, DEPTH = 4, CTXL = 256, FF = 2816, NMOD = 9;
constexpr int RL = NB * SEQ;
constexpr int RC = NB * CTXL;
constexpr int R = RL + RC;
constexpr int INW = 2304;
constexpr float EPS = 1e-6f;
constexpr float LOG2E = 1.4426950408889634f;
constexpr int NTHREADS = 512, NWAVES = 8;

constexpr size_t MiB = 1u << 20;
constexpr size_t WS_CTL = 0;
constexpr size_t WS_MODV = 1 * MiB;
constexpr size_t WS_GTAB = WS_MODV + 768 * 1024;
constexpr size_t WS_W = 2 * MiB;
constexpr size_t W_1IN = 0;
constexpr size_t W_1OUT = W_1IN + (size_t)5632 * 1024 * 2;
constexpr size_t W_MIX = W_1OUT + (size_t)1024 * 2816 * 2;
constexpr size_t W_OUT = W_MIX + (size_t)2304 * 1024 * 2;
constexpr size_t W_2IN = W_OUT + (size_t)1024 * 1024 * 2;
constexpr size_t W_2OUT = W_2IN + (size_t)5632 * 1024 * 2;
constexpr size_t LAYER_W_BYTES = W_2OUT + (size_t)1024 * 2816 * 2;
constexpr size_t WS_XRES = WS_W + DEPTH * LAYER_W_BYTES;
constexpr size_t WS_H = WS_XRES + (size_t)R * DM * 4;
constexpr size_t WS_ACT = WS_H + (size_t)R * DM * 2;
constexpr size_t WS_PART = WS_ACT + (size_t)R * FF * 2;
constexpr size_t WS_END = WS_PART + (size_t)11 * RC * DM * 4;
constexpr size_t MX_QA = 0;
constexpr size_t MX_KA = MX_QA + (size_t)6 * R * 64 * 2;
constexpr size_t MX_QC = MX_KA + (size_t)2 * R * 64 * 2;
constexpr size_t MX_KC = MX_QC + (size_t)8 * R * 48 * 2;
constexpr size_t MX_U = MX_KC + (size_t)8 * R * 48 * 2;
constexpr size_t MX_VG = MX_U + (size_t)R * 256 * 2;
constexpr size_t MX_VT = MX_VG + (size_t)R * 256 * 2;
static_assert(MX_VT + (size_t)512 * R * 2 <= (size_t)R * FF * 2, "mixer overlay fits");

constexpr int LDS_MAIN = 131072;
constexpr int LDS_MISC = LDS_MAIN;
constexpr int LDS_BYTES = LDS_MAIN + 256;

typedef __bf16 bf16x2_t __attribute__((ext_vector_type(2)));
__device__ __forceinline__ unsigned cvt_pk_bf16(float lo, float hi) { const f32x2 v = {lo, hi}; const bf16x2_t b = __builtin_convertvector(v, bf16x2_t); return __builtin_bit_cast(unsigned, b); }
__device__ __forceinline__ float bf2f(bf16_t v) { return __uint_as_float(((unsigned)v) << 16); }
__device__ __forceinline__ float fast_exp2(float x) { return __builtin_amdgcn_exp2f(x); }
__device__ __forceinline__ float fast_rcp(float x) { return __builtin_amdgcn_rcpf(x); }
__device__ __forceinline__ float silu_f(float x) { return x * fast_rcp(1.0f + fast_exp2(-x * LOG2E)); }
__device__ __forceinline__ float gelu_tanh_f(float x) { const float u = 0.7978845608028654f * (x + 0.044715f * x * x * x); return x * fast_rcp(1.0f + fast_exp2(-2.0f * LOG2E * u)); }
template <int M> __device__ __forceinline__ float swz_xor(float v) { return __builtin_bit_cast(float, __builtin_amdgcn_ds_swizzle(__builtin_bit_cast(int, v), (M << 10) | 0x1f)); }
__device__ __forceinline__ float max3f(float a, float b, float c) { return __builtin_elementwise_maximum(__builtin_elementwise_maximum(a, b), c); }
__device__ __forceinline__ float xadd32(float v) { auto rr = __builtin_amdgcn_permlane32_swap(__float_as_uint(v), __float_as_uint(v), false, false); return __uint_as_float(rr[0]) + __uint_as_float(rr[1]); }
__device__ __forceinline__ float xmax32(float v) { auto rr = __builtin_amdgcn_permlane32_swap(__float_as_uint(v), __float_as_uint(v), false, false); const float a = __uint_as_float(rr[0]), b = __uint_as_float(rr[1]); return max3f(a, b, b); }
__device__ __forceinline__ float sum32(float v) { v += swz_xor<1>(v); v += swz_xor<2>(v); v += swz_xor<4>(v); v += swz_xor<8>(v); v += swz_xor<16>(v); return v; }
__device__ __forceinline__ float wave_sum(float v) { return xadd32(sum32(v)); }
__device__ __forceinline__ int opaque_tid() { int t = threadIdx.x; asm volatile("" : "+v"(t)); return t; }
__device__ __forceinline__ int crow(int r, int hi) { return (r & 3) + 8 * (r >> 2) + 4 * hi; }

#define XB_TMO      128
#define XB_XCNT(j)  (256  + 64 * (j))
#define XB_XSUB(j)  (1280 + 64 * (j))
#define XB_XGEN(j)  (2304 + 64 * (j))
#define XB_TOP      3328
#define XB_TOPGEN   3392
#define XCD_BAR_WORDS 3456
#define XB_SPIN_CAP (1u << 22)
__device__ __forceinline__ unsigned xb_ld(unsigned* p)              { return __hip_atomic_load(p, __ATOMIC_RELAXED, __HIP_MEMORY_SCOPE_AGENT); }
__device__ __forceinline__ unsigned xb_add(unsigned* p, unsigned v) { return __hip_atomic_fetch_add(p, v, __ATOMIC_RELAXED, __HIP_MEMORY_SCOPE_AGENT); }
__device__ __forceinline__ unsigned xb_xcc_id() { return (unsigned)__builtin_amdgcn_s_getreg((3 << 11) | 20) & 0xFu; }
#define XB_SPIN(cond, bar) do { unsigned _sp = 0; while (cond) { __builtin_amdgcn_s_sleep(1); \
    if ((++_sp & 255u) == 0u) { if (xb_ld(&(bar)[XB_TMO])) break; if (_sp > XB_SPIN_CAP) { atomicAdd(&(bar)[XB_TMO], 1u); break; } } } } while (0)
struct XcdBarrier { unsigned* bar; unsigned x; volatile LAS unsigned* st; };
__device__ __forceinline__ XcdBarrier xcd_barrier_post(unsigned* bar, volatile LAS unsigned* st) {
    XcdBarrier b; b.bar = bar; b.x = xb_xcc_id(); b.st = st;
    if (threadIdx.x == 0) (void)xb_add(&bar[XB_XCNT(b.x)], 1u);
    return b;
}
__device__ __forceinline__ void xcd_barrier_complete(unsigned* bar, unsigned x, unsigned& nloc, unsigned& nx) {
    const unsigned G = gridDim.x * gridDim.y * gridDim.z;
    unsigned sum, cnt, mine, sp = 0u;
    for (;;) {
        sum = 0u; cnt = 0u; mine = 0u;
#pragma unroll
        for (unsigned j = 0; j < 16; ++j) { const unsigned c = xb_ld(&bar[XB_XCNT(j)]); sum += c; cnt += (c > 0u) ? 1u : 0u; mine = (j == x) ? c : mine; }
        if (sum == G) break;
        __builtin_amdgcn_s_sleep(1);
        if ((++sp & 255u) == 0u) { if (xb_ld(&bar[XB_TMO])) break; if (sp > XB_SPIN_CAP) { atomicAdd(&bar[XB_TMO], 1u); break; } }
    }
    nloc = mine > 0u ? mine : 1u; nx = cnt > 0u ? cnt : 1u;
}
__device__ __forceinline__ void xcd_barrier(const XcdBarrier& b) {
    asm volatile("s_waitcnt vmcnt(0)" ::: "memory");
    __syncthreads();
    if (opaque_tid() == 0) {
        unsigned* bar = b.bar;
        __builtin_amdgcn_s_waitcnt(0);
        unsigned nloc = b.st[0], nx = b.st[1];
        if (nloc == 0u) { xcd_barrier_complete(bar, b.x, nloc, nx); b.st[0] = nloc; b.st[1] = nx; }
        const unsigned old = xb_add(&bar[XB_XSUB(b.x)], 1u);
        const unsigned gen = old / nloc;
        if (old + 1u == (gen + 1u) * nloc) {
            __builtin_amdgcn_fence(__ATOMIC_RELEASE, "agent");
            asm volatile("s_waitcnt vmcnt(0)" ::: "memory");
            const unsigned og = xb_add(&bar[XB_TOP], 1u);
            const unsigned tg = og / nx;
            if (og + 1u == (tg + 1u) * nx) xb_add(&bar[XB_TOPGEN], 1u);
            else XB_SPIN(xb_ld(&bar[XB_TOPGEN]) == tg, bar);
            __builtin_amdgcn_fence(__ATOMIC_ACQUIRE, "agent");
            xb_add(&bar[XB_XGEN(b.x)], 1u);
            asm volatile("s_waitcnt vmcnt(0)" ::: "memory");
        } else {
            XB_SPIN(xb_ld(&bar[XB_XGEN(b.x)]) == gen, bar);
            __builtin_amdgcn_fence(__ATOMIC_ACQUIRE, "agent");
            asm volatile("s_waitcnt vmcnt(0)" ::: "memory");
        }
    }
    __syncthreads();
}

namespace pg8 {
constexpr int BM = 256, BK = 64, HALF = 128, HTB = HALF * BK * 2, STAGE_BYTES = 8 * HTB, NXCD = 8, WGM = 8;
__device__ __forceinline__ int lds_byte(int r, int c) { const int st = (r >> 4) * 2 + (c >> 5), rr = r & 15, cc = c & 31, ob = rr * 64 + cc * 2; return st * 1024 + (ob ^ (((ob >> 9) & 1) << 5)); }
__device__ __forceinline__ void stage_rc(int b, int& Rr, int& C) { const int st = b / 1024, sb = b % 1024, swz = sb ^ (((sb >> 9) & 1) << 5); Rr = (st >> 1) * 16 + swz / 64; C = (st & 1) * 32 + (swz % 64) / 2; }
__device__ __forceinline__ int perm32(int rho) { const int n = rho >> 4, i = rho & 15; return 8 * (i >> 2) + 4 * n + (i & 3); }

struct Unit { const char* a; const char* b; int pm, pn, kind, nt; };

__device__ __forceinline__ void order_map(int L, int nM, int nN, int& pm, int& pn) {
    const int nwg = nM * nN; int wgid = L;
    { const int q = nwg / NXCD, r = nwg % NXCD, xcd = wgid % NXCD, off = wgid / NXCD; wgid = (xcd < r ? xcd * (q + 1) : r * (q + 1) + (xcd - r) * q) + off; }
    const int nig = WGM * nN, gid = wgid / nig, fm = gid * WGM, gsz = (nM - fm) < WGM ? (nM - fm) : WGM;
    pm = fm + ((wgid % nig) % gsz); pn = (wgid % nig) / gsz;
}
struct SchedOne {
    const char* A; const char* B; int nM, nN, G, c; size_t tstep; int nt;
    __device__ __forceinline__ bool next(int i, Unit& u) const {
        const long L = (long)i * G + c; if (L >= (long)nM * nN) return false;
        int pm, pn; order_map((int)L, nM, nN, pm, pn);
        u.pm = pm; u.pn = pn; u.kind = 0; u.nt = nt; u.a = A + (size_t)pm * tstep; u.b = B + (size_t)pn * tstep; return true;
    }
};
struct SchedDown {
    const char* A; const char* B; int G, c; size_t tstep; int nt, nctx, nsplit, ntc;
    __device__ __forceinline__ bool next(int i, Unit& u) const {
        const long L = (long)i * G + c; constexpr int n1 = 128 * 4; const int nsub = nctx * 4 * nsplit;
        if (L >= n1 + nsub) return false;
        int pm, pn;
        if (L >= nsub) { order_map((int)L - nsub, 128, 4, pm, pn); u.kind = 0; u.nt = nt; u.a = A + (size_t)pm * tstep; u.b = B + (size_t)pn * tstep; }
        else { const int j = (int)L, ks = j % nsplit, tile = j / nsplit; pm = 128 + (tile >> 2); pn = tile & 3; u.kind = 1 + ks; u.nt = ntc;
               u.a = A + (size_t)pm * tstep + (size_t)ks * ntc * 128; u.b = B + (size_t)pn * tstep + (size_t)ks * ntc * 128; }
        u.pm = pm; u.pn = pn; return true;
    }
};
struct SchedMix {
    const char* H; const char* Wm; const char* Wv; int G, c; size_t tstep;
    __device__ __forceinline__ bool next(int i, Unit& u) const {
        const long L = (long)i * G + c; constexpr int n1 = 132 * 7, n2 = 2 * 132;
        if (L >= n1 + n2) return false;
        int pm, pn;
        if (L < n1) { order_map((int)L, 132, 7, pm, pn); u.kind = 0; u.nt = 16; u.a = H + (size_t)pm * tstep; u.b = Wm + (size_t)pn * tstep; }
        else { order_map((int)L - n1, 2, 132, pm, pn); u.kind = 1; u.nt = 16; u.a = Wv + (size_t)pm * tstep; u.b = H + (size_t)pn * tstep; }
        u.pm = pm; u.pn = pn; return true;
    }
};

template <class Epi, class Sched, bool ALIGN_EPI = true, bool SP2 = true>
__device__ __forceinline__ void gemm_phase(LAS unsigned char* lds, const int K, const Sched& S, const Epi& E) {
    const int tid = opaque_tid(), wid = __builtin_amdgcn_readfirstlane(tid >> 6), lane = tid & 63, wr = wid >> 2, wc = wid & 3, fr = lane & 15, fq = lane >> 4;
    unsigned voffA[2], voffB[2];
#pragma unroll
    for (int i = 0; i < 2; ++i) { int Rr, C; stage_rc(tid * 16 + i * 8192, Rr, C); const int Rb = Epi::PERM ? ((Rr & ~31) + perm32(Rr & 31)) : Rr;
        voffA[i] = (unsigned)(Rr * K + C) * 2u; voffB[i] = (unsigned)(Rb * K + C) * 2u; }
    const size_t kstep = (size_t)(BK * 2);
    const size_t hstep = (size_t)HALF * K * 2;
    const unsigned ldsw = (unsigned)wid * 1024u;
    const int aoff = lds_byte(wr * 64 + fr, fq * 8), boff = lds_byte(wc * 32 + fr, fq * 8);
#define PG8_SA(b, h) (((b) * 2 + (h)) * HTB)
#define PG8_SB(b, h) ((4 + (b) * 2 + (h)) * HTB)
#define PG8_STAGE(bufoff, gbase, voff) do { _Pragma("unroll") for (int _i = 0; _i < 2; ++_i) \
        __builtin_amdgcn_global_load_lds((const unsigned*)((const char*)(gbase) + (voff)[_i]), (LAS unsigned*)(lds + (bufoff) + ldsw + _i * 8192), 16, 0, 0); } while (0)
#define PG8_LDA(dst, b, h) do { _Pragma("unroll") for (int m = 0; m < 4; ++m) _Pragma("unroll") for (int k = 0; k < 2; ++k) dst[m][k] = *(const LAS bf16x8*)(lds + PG8_SA(b, h) + aoff + m * 2048 + k * 1024); } while (0)
#define PG8_LDB(dst, b, h) do { _Pragma("unroll") for (int n = 0; n < 2; ++n) _Pragma("unroll") for (int k = 0; k < 2; ++k) dst[n][k] = *(const LAS bf16x8*)(lds + PG8_SB(b, h) + boff + n * 2048 + k * 1024); } while (0)
#define PG8_MMA(ai, bj, At, Bt) do { __builtin_amdgcn_s_setprio(1); _Pragma("unroll") for (int m = 0; m < 4; ++m) _Pragma("unroll") for (int n = 0; n < 2; ++n) _Pragma("unroll") for (int k = 0; k < 2; ++k) \
        acc[ai][bj][m][n] = __builtin_amdgcn_mfma_f32_16x16x32_bf16(Bt[n][k], At[m][k], acc[ai][bj][m][n], 0, 0, 0); __builtin_amdgcn_s_setprio(0); } while (0)
#define PG8_WAIT_V(n) asm volatile("s_waitcnt vmcnt(" #n ")" ::: "memory")
#define PG8_WAIT_L(n) asm volatile("s_waitcnt lgkmcnt(" #n ")" ::: "memory")
#define PG8_BAR __builtin_amdgcn_s_barrier()
#define PG8_SCHED __builtin_amdgcn_sched_barrier(0)
    Unit cur, nxt; int ui = 0;
    if (!S.next(0, cur)) return;
    f32x4 acc[2][2][4][2];
#pragma unroll
    for (int a = 0; a < 2; ++a)
#pragma unroll
        for (int b = 0; b < 2; ++b)
#pragma unroll
            for (int m = 0; m < 4; ++m)
#pragma unroll
                for (int n = 0; n < 2; ++n) acc[a][b][m][n] = (f32x4){0.f, 0.f, 0.f, 0.f};
    bf16x8 At[4][2], B0[2][2], B1[2][2];
    const char* cA = cur.a; const char* cB = cur.b;
    if constexpr (SP2) {
        PG8_STAGE(PG8_SB(0, 0), cB, voffB); PG8_STAGE(PG8_SB(0, 1), cB + hstep, voffB); PG8_STAGE(PG8_SA(0, 0), cA, voffA); PG8_STAGE(PG8_SA(0, 1), cA + hstep, voffA);
        if (wr == 1) PG8_BAR;
        PG8_WAIT_V(2); PG8_BAR;
        PG8_STAGE(PG8_SB(1, 0), cB + kstep, voffB); PG8_STAGE(PG8_SA(1, 0), cA + kstep, voffA); PG8_STAGE(PG8_SB(1, 1), cB + hstep + kstep, voffB);
        PG8_WAIT_V(6); PG8_BAR;
    } else {
        PG8_STAGE(PG8_SB(0, 0), cB, voffB); PG8_STAGE(PG8_SA(0, 0), cA, voffA); PG8_STAGE(PG8_SB(0, 1), cB + hstep, voffB); PG8_STAGE(PG8_SA(0, 1), cA + hstep, voffA);
        if (wr == 1) PG8_BAR;
        PG8_WAIT_V(4); PG8_BAR;
        PG8_STAGE(PG8_SB(1, 0), cB + kstep, voffB); PG8_STAGE(PG8_SA(1, 0), cA + kstep, voffA); PG8_STAGE(PG8_SB(1, 1), cB + hstep + kstep, voffB);
        PG8_WAIT_V(6); PG8_BAR;
    }
    for (;;) {
        const bool has_next = S.next(ui + 1, nxt);
        const char* nA = has_next ? nxt.a : cA; const char* nB = has_next ? nxt.b : cB;
        const int nt = cur.nt;
        for (int t = 0; t < nt; t += 2) {
            const bool last = (t == nt - 2);
            const char* a1 = cA + (size_t)(t + 1) * kstep;
            const char* a2 = last ? nA : cA + (size_t)(t + 2) * kstep; const char* b2 = last ? nB : cB + (size_t)(t + 2) * kstep;
            const char* a3 = a2 + kstep; const char* b3 = b2 + kstep;
            if constexpr (SP2) {
            PG8_LDB(B0, 0, 0); PG8_LDB(B1, 0, 1); PG8_SCHED; PG8_LDA(At, 0, 0); PG8_STAGE(PG8_SA(1, 1), a1 + hstep, voffA);
            PG8_WAIT_V(8); PG8_WAIT_L(0); PG8_BAR; PG8_MMA(0, 0, At, B0); PG8_MMA(0, 1, At, B1); PG8_BAR; PG8_SCHED;
            PG8_LDA(At, 0, 1); PG8_STAGE(PG8_SB(0, 0), b2, voffB); PG8_STAGE(PG8_SB(0, 1), b2 + hstep, voffB); PG8_STAGE(PG8_SA(0, 0), a2, voffA);
            PG8_WAIT_V(8); PG8_WAIT_L(0); PG8_BAR; PG8_MMA(1, 0, At, B0); PG8_MMA(1, 1, At, B1); PG8_BAR; PG8_SCHED;
            PG8_LDB(B0, 1, 0); PG8_LDB(B1, 1, 1); PG8_SCHED; PG8_LDA(At, 1, 0); PG8_STAGE(PG8_SA(0, 1), a2 + hstep, voffA);
            PG8_WAIT_V(8); PG8_WAIT_L(0); PG8_BAR; PG8_MMA(0, 0, At, B0); PG8_MMA(0, 1, At, B1); PG8_BAR; PG8_SCHED;
            PG8_LDA(At, 1, 1); PG8_STAGE(PG8_SB(1, 0), b3, voffB); PG8_STAGE(PG8_SB(1, 1), b3 + hstep, voffB); PG8_STAGE(PG8_SA(1, 0), a3, voffA);
            PG8_WAIT_V(8); PG8_WAIT_L(0); PG8_BAR; PG8_MMA(1, 0, At, B0); PG8_MMA(1, 1, At, B1); PG8_BAR; PG8_SCHED;
            } else {
            PG8_LDB(B0, 0, 0); PG8_SCHED; PG8_LDA(At, 0, 0); PG8_STAGE(PG8_SA(1, 1), a1 + hstep, voffA);
            PG8_WAIT_L(8); PG8_BAR; PG8_WAIT_L(0); PG8_MMA(0, 0, At, B0); PG8_BAR; PG8_SCHED;
            PG8_LDB(B1, 0, 1); PG8_STAGE(PG8_SB(0, 0), b2, voffB);
            PG8_BAR; PG8_WAIT_L(0); PG8_MMA(0, 1, At, B1); PG8_BAR;
            PG8_LDA(At, 0, 1); PG8_STAGE(PG8_SA(0, 0), a2, voffA);
            PG8_BAR; PG8_WAIT_L(0); PG8_MMA(1, 0, At, B0); PG8_BAR; PG8_SCHED;
            PG8_STAGE(PG8_SB(0, 1), b2 + hstep, voffB);
            PG8_WAIT_V(6); PG8_BAR; PG8_MMA(1, 1, At, B1); PG8_BAR;
            PG8_LDB(B0, 1, 0); PG8_SCHED; PG8_LDA(At, 1, 0); PG8_STAGE(PG8_SA(0, 1), a2 + hstep, voffA);
            PG8_WAIT_L(8); PG8_BAR; PG8_WAIT_L(0); PG8_MMA(0, 0, At, B0); PG8_BAR; PG8_SCHED;
            PG8_LDB(B1, 1, 1); PG8_STAGE(PG8_SB(1, 0), b3, voffB);
            PG8_BAR; PG8_WAIT_L(0); PG8_MMA(0, 1, At, B1); PG8_BAR;
            PG8_LDA(At, 1, 1); PG8_STAGE(PG8_SA(1, 0), a3, voffA);
            PG8_BAR; PG8_WAIT_L(0); PG8_MMA(1, 0, At, B0); PG8_BAR; PG8_SCHED;
            PG8_STAGE(PG8_SB(1, 1), b3 + hstep, voffB);
            PG8_WAIT_V(6); PG8_BAR; PG8_MMA(1, 1, At, B1); PG8_BAR;
            }
        }
        if constexpr (ALIGN_EPI) { if (wr == 0) PG8_BAR; }
        E(acc, cur, wr, wc, fr, fq);
        if (!has_next) break;
#pragma unroll
        for (int a = 0; a < 2; ++a)
#pragma unroll
            for (int b = 0; b < 2; ++b)
#pragma unroll
                for (int m = 0; m < 4; ++m)
#pragma unroll
                    for (int n = 0; n < 2; ++n) acc[a][b][m][n] = (f32x4){0.f, 0.f, 0.f, 0.f};
        cur = nxt; cA = nA; cB = nB; ++ui;
        if constexpr (ALIGN_EPI) { if (wr == 1) PG8_BAR; }
    }
    PG8_WAIT_V(0);
    if constexpr (!ALIGN_EPI) { if (wr == 0) PG8_BAR; }
    PG8_BAR;
#undef PG8_SA
#undef PG8_SB
#undef PG8_STAGE
#undef PG8_LDA
#undef PG8_LDB
#undef PG8_MMA
#undef PG8_WAIT_V
#undef PG8_WAIT_L
#undef PG8_BAR
#undef PG8_SCHED
}

struct EpiUp {
    static constexpr bool PERM = true;
    bf16_t* act;
    __device__ __forceinline__ void operator()(const f32x4 (&acc)[2][2][4][2], const Unit& u, int wr, int wc, int fr, int fq) const {
        asm volatile("" : "+v"(fr), "+v"(fq));
        const int row0 = u.pm * BM + wr * 64 + fr; const int col0 = u.pn * 128 + wc * 32 + 8 * fq;
#pragma unroll
        for (int ai = 0; ai < 2; ++ai)
#pragma unroll
            for (int m = 0; m < 4; ++m) {
                bf16_t* rowp = act + (size_t)(row0 + ai * HALF + m * 16) * FF + col0;
                const f32x4 g0 = acc[ai][0][m][0], g1 = acc[ai][0][m][1], u0 = acc[ai][1][m][0], u1 = acc[ai][1][m][1];
                u32x4 w;
                w.x = cvt_pk_bf16(silu_f(g0[0]) * u0[0], silu_f(g0[1]) * u0[1]); w.y = cvt_pk_bf16(silu_f(g0[2]) * u0[2], silu_f(g0[3]) * u0[3]);
                w.z = cvt_pk_bf16(silu_f(g1[0]) * u1[0], silu_f(g1[1]) * u1[1]); w.w = cvt_pk_bf16(silu_f(g1[2]) * u1[2], silu_f(g1[3]) * u1[3]);
                *(u32x4*)rowp = w;
            }
    }
};
struct EpiDown {
    static constexpr bool PERM = true;
    const float* xoldL; const float* xoldC; float* xnew; const float* gate; float gscale; float* part;
    __device__ __forceinline__ void operator()(const f32x4 (&acc)[2][2][4][2], const Unit& u, int wr, int wc, int fr, int fq) const {
        asm volatile("" : "+v"(fr), "+v"(fq));
        const int s = u.pm < 128 ? (u.pm >> 5) : 4;
        const int row0 = u.pm * BM + wr * 64 + fr; const int col0 = u.pn * BM + wc * 32 + 8 * fq;
        const float* xo = (u.pm < 128) ? xoldL + (size_t)row0 * DM : xoldC + (size_t)(row0 - RL) * DM;
        float* xn = xnew + (size_t)row0 * DM;
        const bool partial = (u.kind >= 1);
        float* pp = part + ((size_t)(u.kind - 1) * RC + (row0 - RL)) * DM;
        f32x4 gv[2][2];
#pragma unroll
        for (int bj = 0; bj < 2; ++bj)
#pragma unroll
            for (int n = 0; n < 2; ++n) gv[bj][n] = *(const f32x4*)(gate + (size_t)s * 9216 + col0 + bj * HALF + 4 * n) * gscale;
        if (partial) {
#pragma unroll
            for (int ai = 0; ai < 2; ++ai)
#pragma unroll
                for (int m = 0; m < 4; ++m) {
                    const size_t ro = (size_t)(ai * HALF + m * 16) * DM + col0;
#pragma unroll
                    for (int bj = 0; bj < 2; ++bj)
#pragma unroll
                        for (int n = 0; n < 2; ++n) *(f32x4*)(pp + ro + bj * HALF + 4 * n) = acc[ai][bj][m][n];
                }
        } else {
#pragma unroll
            for (int ai = 0; ai < 2; ++ai) {
                f32x4 xv[4][2][2];
#pragma unroll
                for (int m = 0; m < 4; ++m)
#pragma unroll
                    for (int bj = 0; bj < 2; ++bj)
#pragma unroll
                        for (int n = 0; n < 2; ++n) xv[m][bj][n] = *(const f32x4*)(xo + (size_t)(ai * HALF + m * 16) * DM + col0 + bj * HALF + 4 * n);
                __builtin_amdgcn_sched_barrier(0);
#pragma unroll
                for (int m = 0; m < 4; ++m)
#pragma unroll
                    for (int bj = 0; bj < 2; ++bj)
#pragma unroll
                        for (int n = 0; n < 2; ++n) *(f32x4*)(xn + (size_t)(ai * HALF + m * 16) * DM + col0 + bj * HALF + 4 * n) = xv[m][bj][n] + gv[bj][n] * acc[ai][bj][m][n];
                __builtin_amdgcn_sched_barrier(0);
            }
        }
    }
};
struct EpiMix {
    static constexpr bool PERM = true;
    unsigned char* mx;
    const float* gq; const float* gk;
    __device__ __forceinline__ void operator()(const f32x4 (&acc)[2][2][4][2], const Unit& u, int wr, int wc, int fr, int fq) const {
        asm volatile("" : "+v"(fr), "+v"(fq));
        if (u.kind == 1) {
            bf16_t* O = (bf16_t*)(mx + MX_VT);
            const int row0 = u.pm * BM + wr * 64 + fr, col0 = u.pn * BM + wc * 32 + 8 * fq;
#pragma unroll
            for (int ai = 0; ai < 2; ++ai)
#pragma unroll
                for (int m = 0; m < 4; ++m) { bf16_t* rowp = O + (size_t)(row0 + ai * HALF + m * 16) * R + col0;
#pragma unroll
                    for (int bj = 0; bj < 2; ++bj) { const f32x4 v0 = acc[ai][bj][m][0], v1 = acc[ai][bj][m][1]; u32x4 w;
                        w.x = cvt_pk_bf16(v0[0], v0[1]); w.y = cvt_pk_bf16(v0[2], v0[3]); w.z = cvt_pk_bf16(v1[0], v1[1]); w.w = cvt_pk_bf16(v1[2], v1[3]);
                        *(u32x4*)(rowp + bj * HALF) = w; } }
            return;
        }
        const int row0 = u.pm * BM + wr * 64 + fr;
        const bool latent = u.pm < 128;
        if (u.pn <= 1) {
            const int slot = u.pn * 4 + wc; const bool isq = slot < 6;
            const float* g = isq ? gq : gk;
            bf16_t* dst = isq ? (bf16_t*)(mx + MX_QA) + (size_t)slot * R * 64 : (bf16_t*)(mx + MX_KA) + (size_t)(slot - 6) * R * 64;
            float fr0[2], fr1[2];
#pragma unroll
            for (int n = 0; n < 2; ++n) { const float p = (float)(4 * fq + 2 * n);
                fr0[n] = fast_exp2(-p * (13.287712379549449f / 16.0f)) * 0.15915494309189535f; fr1[n] = fast_exp2(-(p + 1.0f) * (13.287712379549449f / 16.0f)) * 0.15915494309189535f; }
#pragma unroll
            for (int ai = 0; ai < 2; ++ai)
#pragma unroll
                for (int m = 0; m < 4; ++m) {
                    const int row = row0 + ai * HALF + m * 16;
                    int fqo = fq; asm volatile("" : "+v"(fqo));
                    f32x4 v[2][2]; float ss = 0.f;
#pragma unroll
                    for (int bj = 0; bj < 2; ++bj)
#pragma unroll
                        for (int n = 0; n < 2; ++n) { v[bj][n] = acc[ai][bj][m][n]; ss += (v[bj][n][0] * v[bj][n][0] + v[bj][n][1] * v[bj][n][1]) + (v[bj][n][2] * v[bj][n][2] + v[bj][n][3] * v[bj][n][3]); }
                    ss += swz_xor<16>(ss); ss = xadd32(ss);
                    const float rstd = __builtin_amdgcn_rsqf(ss * (1.0f / 64.0f) + EPS);
                    const int t = row & (SEQ - 1); const float pos[2] = {(float)(t >> 6), (float)(t & 63)};
#pragma unroll
                    for (int bj = 0; bj < 2; ++bj) {
                        u32x4 w;
#pragma unroll
                        for (int n = 0; n < 2; ++n) {
                            f32x4 x = v[bj][n] * rstd * *(const f32x4*)(g + 32 * bj + 8 * fqo + 4 * n);
                            if (latent) {
                                const float a0 = pos[bj] * fr0[n], a1 = pos[bj] * fr1[n];
                                const float c0 = __builtin_amdgcn_cosf(a0), s0 = __builtin_amdgcn_sinf(a0), c1 = __builtin_amdgcn_cosf(a1), s1 = __builtin_amdgcn_sinf(a1);
                                x = (f32x4){x[0] * c0 - x[1] * s0, x[1] * c0 + x[0] * s0, x[2] * c1 - x[3] * s1, x[3] * c1 + x[2] * s1};
                            }
                            if (n == 0) { w.x = cvt_pk_bf16(x[0], x[1]); w.y = cvt_pk_bf16(x[2], x[3]); } else { w.z = cvt_pk_bf16(x[0], x[1]); w.w = cvt_pk_bf16(x[2], x[3]); }
                        }
                        *(u32x4*)(dst + (size_t)row * 64 + 32 * bj + 8 * fq) = w;
                    }
                    __builtin_amdgcn_sched_barrier(0);
                }
        } else if (u.pn <= 3) {
            bf16_t* dst = (bf16_t*)(mx + (u.pn == 2 ? MX_U : MX_VG));
            const int col0 = wc * 32 + 8 * fq;
#pragma unroll
            for (int ai = 0; ai < 2; ++ai)
#pragma unroll
                for (int m = 0; m < 4; ++m) { bf16_t* rowp = dst + (size_t)(row0 + ai * HALF + m * 16) * 256 + col0;
#pragma unroll
                    for (int bj = 0; bj < 2; ++bj) { const f32x4 v0 = acc[ai][bj][m][0], v1 = acc[ai][bj][m][1]; u32x4 w;
                        w.x = cvt_pk_bf16(gelu_tanh_f(v0[0]), gelu_tanh_f(v0[1])); w.y = cvt_pk_bf16(gelu_tanh_f(v0[2]), gelu_tanh_f(v0[3]));
                        w.z = cvt_pk_bf16(gelu_tanh_f(v1[0]), gelu_tanh_f(v1[1])); w.w = cvt_pk_bf16(gelu_tanh_f(v1[2]), gelu_tanh_f(v1[3]));
                        *(u32x4*)(rowp + bj * HALF) = w; } }
        } else {
#pragma unroll
            for (int bj = 0; bj < 2; ++bj) {
                const int j = (u.pn - 4) * 256 + 128 * bj + 32 * wc + 8 * fq;
                const int which = j >= 384 ? 1 : 0; const int rem = j - which * 384; const int ch = rem / 48; const int sidx = rem - ch * 48;
                const int blk = sidx >= 24 ? 1 : 0; const int ii = sidx - blk * 24;
                bf16_t* dst = (bf16_t*)(mx + (which ? MX_KC : MX_QC)) + (size_t)ch * R * 48 + sidx;
                const float qs = which ? 1.0f : 0.14433756729740643f * LOG2E;
                float fq4[4];
#pragma unroll
                for (int e = 0; e < 4; ++e) fq4[e] = fast_exp2(-(float)(ii / 2 + e) * (13.287712379549449f / 12.0f)) * 0.15915494309189535f;
#pragma unroll
                for (int ai = 0; ai < 2; ++ai)
#pragma unroll
                    for (int m = 0; m < 4; ++m) {
                        const int row = row0 + ai * HALF + m * 16;
                        f32x4 x0 = acc[ai][bj][m][0] * qs, x1 = acc[ai][bj][m][1] * qs;
                        if (latent) {
                            const int t = row & (SEQ - 1); const float pos = blk ? (float)(t & 63) : (float)(t >> 6);
                            const float a0 = pos * fq4[0], a1 = pos * fq4[1], a2 = pos * fq4[2], a3 = pos * fq4[3];
                            const float c0 = __builtin_amdgcn_cosf(a0), s0 = __builtin_amdgcn_sinf(a0), c1 = __builtin_amdgcn_cosf(a1), s1 = __builtin_amdgcn_sinf(a1);
                            const float c2 = __builtin_amdgcn_cosf(a2), s2 = __builtin_amdgcn_sinf(a2), c3 = __builtin_amdgcn_cosf(a3), s3 = __builtin_amdgcn_sinf(a3);
                            x0 = (f32x4){x0[0] * c0 - x0[1] * s0, x0[1] * c0 + x0[0] * s0, x0[2] * c1 - x0[3] * s1, x0[3] * c1 + x0[2] * s1};
                            x1 = (f32x4){x1[0] * c2 - x1[1] * s2, x1[1] * c2 + x1[0] * s2, x1[2] * c3 - x1[3] * s3, x1[3] * c3 + x1[2] * s3};
                        }
                        u32x4 w; w.x = cvt_pk_bf16(x0[0], x0[1]); w.y = cvt_pk_bf16(x0[2], x0[3]); w.z = cvt_pk_bf16(x1[0], x1[1]); w.w = cvt_pk_bf16(x1[2], x1[3]);
                        *(u32x4*)(dst + (size_t)row * 48) = w;
                        __builtin_amdgcn_sched_barrier(0);
                    }
            }
        }
    }
};
}

struct Args { const float* in[23]; float* out; unsigned char* ws; };
enum { I_X = 0, I_C, I_CTX, I_CCTX, I_WMOD, I_BMOD, I_GFFN1, I_W1IN, I_W1OUT, I_GMIX, I_WMIXIN, I_WMIXOUT, I_GQ, I_GK, I_GV, I_WS, I_BS, I_LAM, I_GSUB, I_GFFN2, I_W2IN, I_W2OUT, I_GFINAL };

__device__ __forceinline__ int ffn_in_src(int n) { const int pn = n >> 8, j = n & 255, bj = j >> 7, jj = j & 127; return bj * FF + pn * 128 + jj; }
__device__ __forceinline__ int mix_in_src(int n) {
    if (n < 512) { const int tile = n >> 8, j = n & 255, bj = j >> 7, wc = (j & 127) >> 5, i = j & 31; const int slot = tile * 4 + wc; return slot * 64 + bj * 32 + (i >> 1) + 16 * (i & 1); }
    if (n < 768) return 640 + (n - 512);
    if (n < 1024) return 896 + (n - 768);
    if (n < 1792) { const int j = n - 1024, which = j >= 384 ? 1 : 0, rem = j - which * 384, ch = rem / 48, sidx = rem - ch * 48, blk = sidx >= 24 ? 1 : 0, ii = sidx - blk * 24;
        return (which ? 1536 : 1152) + ch * 48 + blk * 24 + (ii >> 1) + 12 * (ii & 1); }
    const int v = n - 1792; return v < 128 ? 512 + v : 1920 + (v - 128);
}
template <int MAP>
__device__ __forceinline__ void transpose_item(const float* W, int K, int N, bf16_t* WT, LAS float* scr, int item, int nblk, int lane) {
    const int kb = item / nblk, nb = item % nblk, k0 = 64 * kb, n0 = 32 * nb;
    const bool contig = (MAP == 0) || (MAP == 1) || (n0 >= 512 && n0 < 1024) || (n0 >= 1792);
    if (contig) {
        const int src0 = MAP == 0 ? n0 : (MAP == 1 ? ffn_in_src(n0) : mix_in_src(n0));
        const int c4 = lane & 7; f32x4 v[8];
#pragma unroll
        for (int i = 0; i < 8; ++i) v[i] = *(const f32x4*)(W + (size_t)(k0 + (lane >> 3) + 8 * i) * N + src0 + 4 * c4);
#pragma unroll
        for (int i = 0; i < 8; ++i) { LAS float* d = scr + ((lane >> 3) + 8 * i) * 33 + 4 * c4; d[0] = v[i][0]; d[1] = v[i][1]; d[2] = v[i][2]; d[3] = v[i][3]; }
    } else {
        const int nn = n0 + (lane & 31); const int src = MAP == 0 ? nn : (MAP == 1 ? ffn_in_src(nn) : mix_in_src(nn));
#pragma unroll 8
        for (int i = 0; i < 32; ++i) { const int kk = 2 * i + (lane >> 5); scr[kk * 33 + (lane & 31)] = W[(size_t)(k0 + kk) * N + src]; }
    }
    asm volatile("s_waitcnt lgkmcnt(0)" ::: "memory");
    const int c = lane & 7;
#pragma unroll
    for (int j = 0; j < 4; ++j) { const int n = (lane >> 3) + 8 * j; const LAS float* s = scr + (8 * c) * 33 + n;
        u32x4 o; o.x = cvt_pk_bf16(s[0 * 33], s[1 * 33]); o.y = cvt_pk_bf16(s[2 * 33], s[3 * 33]); o.z = cvt_pk_bf16(s[4 * 33], s[5 * 33]); o.w = cvt_pk_bf16(s[6 * 33], s[7 * 33]);
        *(u32x4*)(WT + (size_t)(n0 + n) * K + k0 + 8 * c) = o; }
    asm volatile("s_waitcnt lgkmcnt(0)" ::: "memory");
}

__device__ __forceinline__ void phase0(const Args& a, LAS unsigned char* lds, int tid, int lane, int wave) {
    const int G = gridDim.x;
    {
        LAS float* sc = (LAS float*)lds;
        LAS float* red = (LAS float*)(lds + 5 * 1024 * 4);
        for (int i = tid; i < 5 * 1024; i += NTHREADS) { const int s = i >> 10, k = i & 1023; const float v = s < 4 ? a.in[I_C][s * 1024 + k] : a.in[I_CCTX][k]; sc[i] = silu_f(v); }
        __syncthreads();
        float* modv = (float*)(a.ws + WS_MODV);
        for (int u = blockIdx.x; u < DEPTH * 72; u += G) {
            const int l = u / 72, n0 = (u % 72) * 128; const int kq = tid >> 7, col = tid & 127;
            const float* W = a.in[I_WMOD] + (size_t)l * 1024 * 9216 + n0 + col;
            float acc[5] = {0.f, 0.f, 0.f, 0.f, 0.f};
#pragma unroll 8
            for (int k = kq; k < 1024; k += 4) { const float w = W[(size_t)k * 9216];
#pragma unroll
                for (int s = 0; s < 5; ++s) acc[s] += sc[s * 1024 + k] * w; }
#pragma unroll
            for (int s = 0; s < 5; ++s) red[(kq * 5 + s) * 128 + col] = acc[s];
            __syncthreads();
            for (int i = tid; i < 5 * 128; i += NTHREADS) { const int s = i >> 7, c = i & 127;
                const float v = red[(0 * 5 + s) * 128 + c] + red[(1 * 5 + s) * 128 + c] + red[(2 * 5 + s) * 128 + c] + red[(3 * 5 + s) * 128 + c];
                modv[((size_t)l * 5 + s) * 9216 + n0 + c] = v + a.in[I_BMOD][(size_t)l * 9216 + n0 + c]; }
            __syncthreads();
        }
    }
    {
        float* xc = (float*)(a.ws + WS_XRES) + (size_t)RL * DM;
        for (int i = blockIdx.x * NTHREADS + tid; i < RC * DM / 4; i += G * NTHREADS) ((f32x4*)xc)[i] = ((const f32x4*)a.in[I_CTX])[i];
    }
    if (blockIdx.x == 0) {
        float* gt = (float*)(a.ws + WS_GTAB);
        for (int i = tid; i < DEPTH * 128; i += NTHREADS) { const int l = i >> 7, isk = (i >> 6) & 1, sidx = i & 63, bj = sidx >> 5, ii = sidx & 31;
            const int tc = 32 * bj + (ii >> 1) + 16 * (ii & 1);
            gt[i] = isk ? a.in[I_GK][l * 64 + tc] : a.in[I_GQ][l * 64 + tc] * (0.125f * LOG2E); }
    }
    __syncthreads();
    {
        LAS float* scr = (LAS float*)(lds + wave * 16384);
        const int gw = blockIdx.x * NWAVES + wave, NGW = G * NWAVES;
        constexpr int I1 = 16 * 176, I2 = 44 * 32, I3 = 16 * 72, I4 = 16 * 32;
        constexpr int PER_LAYER = I1 + I2 + I3 + I4 + I1 + I2;
        for (int it = gw; it < DEPTH * PER_LAYER; it += NGW) {
            const int l = it / PER_LAYER; int r = it % PER_LAYER;
            unsigned char* wl = a.ws + WS_W + (size_t)l * LAYER_W_BYTES;
            if (r < I1) { transpose_item<1>(a.in[I_W1IN] + (size_t)l * 1024 * 5632, 1024, 5632, (bf16_t*)(wl + W_1IN), scr, r, 176, lane); continue; } r -= I1;
            if (r < I2) { transpose_item<0>(a.in[I_W1OUT] + (size_t)l * 2816 * 1024, 2816, 1024, (bf16_t*)(wl + W_1OUT), scr, r, 32, lane); continue; } r -= I2;
            if (r < I3) { transpose_item<2>(a.in[I_WMIXIN] + (size_t)l * 1024 * 2304, 1024, 2304, (bf16_t*)(wl + W_MIX), scr, r, 72, lane); continue; } r -= I3;
            if (r < I4) { transpose_item<0>(a.in[I_WMIXOUT] + (size_t)l * 1024 * 1024, 1024, 1024, (bf16_t*)(wl + W_OUT), scr, r, 32, lane); continue; } r -= I4;
            if (r < I1) { transpose_item<1>(a.in[I_W2IN] + (size_t)l * 1024 * 5632, 1024, 5632, (bf16_t*)(wl + W_2IN), scr, r, 176, lane); continue; } r -= I1;
            transpose_item<0>(a.in[I_W2OUT] + (size_t)l * 2816 * 1024, 2816, 1024, (bf16_t*)(wl + W_2OUT), scr, r, 32, lane);
        }
    }
}

__device__ __forceinline__ void norm_row(const f32x4 (&v)[4], const f32x4 (&gn)[4], const float* sh, bf16_t* hrow, int lane) {
    const float* scl = sh + 1024;
    f32x4 sv[4], cv[4];
#pragma unroll
    for (int j = 0; j < 4; ++j) { sv[j] = *(const f32x4*)(sh + 4 * lane + 256 * j); cv[j] = *(const f32x4*)(scl + 4 * lane + 256 * j); }
    float ss = 0.f;
#pragma unroll
    for (int j = 0; j < 4; ++j) ss += (v[j][0] * v[j][0] + v[j][1] * v[j][1]) + (v[j][2] * v[j][2] + v[j][3] * v[j][3]);
    const float rstd = __builtin_amdgcn_rsqf(wave_sum(ss) * (1.0f / DM) + EPS);
#pragma unroll
    for (int j = 0; j < 4; ++j) {
        const f32x4 y = v[j] * rstd * gn[j] * (cv[j] + 1.0f) + sv[j];
        u32x2 w; w.x = cvt_pk_bf16(y[0], y[1]); w.y = cvt_pk_bf16(y[2], y[3]);
        *(u32x2*)(hrow + 4 * lane + 256 * j) = w;
    }
}
__device__ __forceinline__ void norm_phase(const float* xL, const float* xC, const float* gain, const float* modl  , int ishift, bf16_t* H, int nrows,
                                           const float* part, int nsplit, const float* pgate  , float pscale, float* xCw) {
    const int tid_ = opaque_tid(); const int lane = tid_ & 63, wave = __builtin_amdgcn_readfirstlane(tid_ >> 6);
    const int gw = blockIdx.x * NWAVES + wave, NGW = gridDim.x * NWAVES;
    f32x4 gn[4];
#pragma unroll
    for (int j = 0; j < 4; ++j) gn[j] = *(const f32x4*)(gain + 4 * lane + 256 * j);
    const int nplain = (nsplit > 0 && nrows > RL) ? RL : nrows;
    {
        int row = gw; f32x4 v[4], vn[4];
        if (row < nplain) { const float* xr = row < RL ? xL + (size_t)row * DM : xC + (size_t)(row - RL) * DM;
#pragma unroll
            for (int j = 0; j < 4; ++j) v[j] = *(const f32x4*)(xr + 4 * lane + 256 * j); }
        for (; row < nplain; row += NGW) {
            const int rn = row + NGW;
            if (rn < nplain) { const float* xr = rn < RL ? xL + (size_t)rn * DM : xC + (size_t)(rn - RL) * DM;
#pragma unroll
                for (int j = 0; j < 4; ++j) vn[j] = *(const f32x4*)(xr + 4 * lane + 256 * j); }
            const int s = row < RL ? (row >> 13) : 4;
            norm_row(v, gn, modl + (size_t)s * 9216 + ishift * 1024, H + (size_t)row * DM, lane);
#pragma unroll
            for (int j = 0; j < 4; ++j) v[j] = vn[j];
        }
    }
    if (nsplit > 0) for (int row = RL + gw; row < nrows; row += NGW) {
        f32x4 v[4];
        const float* xr = xC + (size_t)(row - RL) * DM;
#pragma unroll
        for (int j = 0; j < 4; ++j) v[j] = *(const f32x4*)(xr + 4 * lane + 256 * j);
#pragma unroll
        for (int j = 0; j < 4; ++j) {
            f32x4 pv[11];
#pragma unroll
            for (int ks = 0; ks < 11; ++ks) if (ks < nsplit) pv[ks] = *(const f32x4*)(part + ((size_t)ks * RC + (row - RL)) * DM + 4 * lane + 256 * j);
            f32x4 sum = {0.f, 0.f, 0.f, 0.f};
#pragma unroll
            for (int ks = 0; ks < 11; ++ks) if (ks < nsplit) sum += pv[ks];
            v[j] += sum * (*(const f32x4*)(pgate + 4 * lane + 256 * j) * pscale);
            *(f32x4*)(xCw + (size_t)(row - RL) * DM + 4 * lane + 256 * j) = v[j];
        }
        norm_row(v, gn, modl + (size_t)4 * 9216 + ishift * 1024, H + (size_t)row * DM, lane);
    }
}
__device__ __forceinline__ void final_phase(const float* x, const float* gain, float* out) {
    const int tid_ = opaque_tid(); const int lane = tid_ & 63, wave = __builtin_amdgcn_readfirstlane(tid_ >> 6);
    const int gw = blockIdx.x * NWAVES + wave, NGW = gridDim.x * NWAVES;
    f32x4 gn[4];
#pragma unroll
    for (int j = 0; j < 4; ++j) gn[j] = *(const f32x4*)(gain + 4 * lane + 256 * j);
    int row = gw; f32x4 v[4], vn[4];
    if (row < RL) {
#pragma unroll
        for (int j = 0; j < 4; ++j) v[j] = *(const f32x4*)(x + (size_t)row * DM + 4 * lane + 256 * j); }
    for (; row < RL; row += NGW) {
        const int rn = row + NGW;
        if (rn < RL) {
#pragma unroll
            for (int j = 0; j < 4; ++j) vn[j] = *(const f32x4*)(x + (size_t)rn * DM + 4 * lane + 256 * j); }
        float ss = 0.f;
#pragma unroll
        for (int j = 0; j < 4; ++j) ss += (v[j][0] * v[j][0] + v[j][1] * v[j][1]) + (v[j][2] * v[j][2] + v[j][3] * v[j][3]);
        const float rstd = __builtin_amdgcn_rsqf(wave_sum(ss) * (1.0f / DM) + EPS);
#pragma unroll
        for (int j = 0; j < 4; ++j) *(f32x4*)(out + (size_t)row * DM + 4 * lane + 256 * j) = v[j] * rstd * gn[j];
#pragma unroll
        for (int j = 0; j < 4; ++j) v[j] = vn[j];
    }
}

__device__ __forceinline__ int pi16(int t) { return (t & ~12) | ((t & 8) >> 1) | ((t & 4) << 1); }
template <int NS, int DQK, int DV, bool KSH  >
__device__ __forceinline__ void attn_unit(LAS unsigned char* lds, const bf16_t* Qh0, const bf16_t* Kh0, const int sstride  , const bf16_t* Vt  ,
                                          int qrow0, int bidx, int tlo, int thi, bf16_t* Y  , float lam, const float* gsub, float outscale) {
    constexpr int CK = DQK / 8, KS = DQK / 16, NDB = DV / 32;
    constexpr int NKS = KSH ? 1 : NS;
    constexpr int KBYTES = NKS * CK * 1024, VBYTES = 8 * DV * 16, BUFB = KBYTES + VBYTES;
    constexpr int NKW = NKS * CK, NVP = DV * 8;
    constexpr int NKL = (NKW + NWAVES - 1) / NWAVES, NVL = (NVP + NTHREADS - 1) / NTHREADS;
    const int tid = opaque_tid(), lane = tid & 63, r32 = lane & 31, hi = lane >> 5; const int wid = __builtin_amdgcn_readfirstlane(tid >> 6);
    LAS float* wsf = (LAS float*)(lds + 3 * BUFB) + wid * 64;
    int kg[NKL]; int vg[NVL];
#pragma unroll
    for (int i = 0; i < NKL; ++i) { const int cck = wid + i * NWAVES; const int c2 = cck < NKW ? cck : 0; const int c = c2 / CK, ck = c2 % CK; kg[i] = c * sstride + pi16(lane) * DQK + ck * 8; }
#pragma unroll
    for (int i = 0; i < NVL; ++i) { const int idx = tid + i * NTHREADS; const int id2 = idx < NVP ? idx : 0; const int c8 = id2 / DV, d = id2 % DV; vg[i] = d * R + c8 * 8; }
    auto tokbase = [&](int t) -> int { return t < 128 ? bidx * SEQ + 64 * t : RL + bidx * CTXL + 64 * (t - 128); };
#define ATT_DMA(T, BOFF) do { const int tb_ = tokbase(T); \
        _Pragma("unroll") for (int i_ = 0; i_ < NKL; ++i_) if (wid + i_ * NWAVES < NKW) \
            __builtin_amdgcn_global_load_lds((const unsigned*)(Kh0 + (kg[i_] + tb_ * DQK)), (LAS unsigned*)(lds + (BOFF) + (wid + i_ * NWAVES) * 1024), 16, 0, 0); \
        _Pragma("unroll") for (int i_ = 0; i_ < NVL; ++i_) if (wid * 64 + i_ * NTHREADS < NVP) \
            __builtin_amdgcn_global_load_lds((const unsigned*)(Vt + (vg[i_] + tb_)), (LAS unsigned*)(lds + (BOFF) + KBYTES + (wid * 64 + i_ * NTHREADS) * 16), 16, 0, 0); } while (0)
#define ATT_SYNC() do { asm volatile("s_waitcnt vmcnt(0)" ::: "memory"); __syncthreads(); } while (0)
    constexpr bool QLDS = (NS > 1);
    LAS unsigned char* qlds = lds + 3 * BUFB + 2048 + wid * 1024 + lane * 16;
    bf16x8 qr[QLDS ? 1 : NS][QLDS ? 1 : KS];
#pragma unroll
    for (int c = 0; c < NS; ++c)
#pragma unroll
        for (int d0 = 0; d0 < KS; ++d0) {
            const bf16x8 qv = *(const bf16x8*)(Qh0 + (size_t)c * sstride + (size_t)(qrow0 + wid * 32 + r32) * DQK + d0 * 16 + hi * 8);
            if constexpr (QLDS) *(LAS bf16x8*)(qlds + (c * KS + d0) * 8192) = qv; else qr[c][d0] = qv;
        }
    f32x16 o[NS][NDB];
#pragma unroll
    for (int c = 0; c < NS; ++c)
#pragma unroll
        for (int d = 0; d < NDB; ++d)
#pragma unroll
            for (int r = 0; r < 16; ++r) o[c][d][r] = 0.f;
    float mrun[NS], lrun[NS];
#pragma unroll
    for (int c = 0; c < NS; ++c) { mrun[c] = 0.f; lrun[c] = 0.f; }
    f32x16 pA0, pA1, pB0, pB1;
    bf16x8 pa0, pa1, pa2, pa3;
#define ATT_QK(P0, P1, C, BOFF) do { \
        _Pragma("unroll") for (int r_ = 0; r_ < 16; ++r_) { P0[r_] = -mrun[C]; P1[r_] = -mrun[C]; } \
        const LAS unsigned char* kb_ = lds + (BOFF) + (KSH ? 0 : (C)) * CK * 1024 + hi * 1024 + r32 * 16; \
        int zo_ = 0; asm volatile("" : "+v"(zo_));     \
        _Pragma("unroll") for (int d0_ = 0; d0_ < KS; ++d0_) { \
            const bf16x8 ka_ = *(const LAS bf16x8*)(kb_ + d0_ * 2048), kc_ = *(const LAS bf16x8*)(kb_ + d0_ * 2048 + 512); \
            bf16x8 qf_; if constexpr (QLDS) qf_ = *(const LAS bf16x8*)(qlds + zo_ + ((C) * KS + d0_) * 8192); else qf_ = qr[QLDS ? 0 : (C)][QLDS ? 0 : d0_]; \
            P0 = __builtin_amdgcn_mfma_f32_32x32x16_bf16(ka_, qf_, P0, 0, 0, 0); \
            P1 = __builtin_amdgcn_mfma_f32_32x32x16_bf16(kc_, qf_, P1, 0, 0, 0); } } while (0)
#define ATT_MAX(P0, P1, C, FIRST) do { \
        float rm_ = max3f(P0[0], P1[0], P0[1]), rn_ = max3f(P1[1], P0[2], P1[2]); \
        _Pragma("unroll") for (int r_ = 3; r_ < 15; r_ += 2) { rm_ = max3f(rm_, P0[r_], P1[r_]); rn_ = max3f(rn_, P0[r_ + 1], P1[r_ + 1]); } \
        rm_ = max3f(rm_, P0[15], P1[15]); rm_ = max3f(rm_, rn_, rn_); \
        rm_ = xmax32(rm_); \
        const bool first_ = (FIRST); \
        if (first_ || __any(rm_ > 8.0f)) { \
            const float dl_ = first_ ? rm_ : fmaxf(rm_, 0.f); \
            mrun[C] += dl_; \
            _Pragma("unroll") for (int r_ = 0; r_ < 16; ++r_) { P0[r_] -= dl_; P1[r_] -= dl_; } \
            if (!first_) { \
                const float f_ = fast_exp2(-dl_); lrun[C] *= f_; \
                if (hi == 0) wsf[r32] = f_; \
                asm volatile("s_waitcnt lgkmcnt(0)" ::: "memory"); \
                _Pragma("unroll") for (int r_ = 0; r_ < 16; ++r_) { const float fr_ = wsf[crow(r_, hi)]; \
                    _Pragma("unroll") for (int d_ = 0; d_ < NDB; ++d_) o[C][d_][r_] *= fr_; } \
                asm volatile("s_waitcnt lgkmcnt(0)" ::: "memory"); \
            } } } while (0)
#define ATT_EXP(P0, P1, C) do { \
        float ls_ = 0.f; \
        _Pragma("unroll") for (int r_ = 0; r_ < 16; ++r_) { P0[r_] = fast_exp2(P0[r_]); P1[r_] = fast_exp2(P1[r_]); ls_ += P0[r_] + P1[r_]; } \
        lrun[C] += ls_; \
        u32x4 w0_, w1_, w2_, w3_; \
        w0_.x = cvt_pk_bf16(P0[0], P0[1]); w0_.y = cvt_pk_bf16(P0[2], P0[3]); w0_.z = cvt_pk_bf16(P0[4], P0[5]); w0_.w = cvt_pk_bf16(P0[6], P0[7]); \
        w1_.x = cvt_pk_bf16(P0[8], P0[9]); w1_.y = cvt_pk_bf16(P0[10], P0[11]); w1_.z = cvt_pk_bf16(P0[12], P0[13]); w1_.w = cvt_pk_bf16(P0[14], P0[15]); \
        w2_.x = cvt_pk_bf16(P1[0], P1[1]); w2_.y = cvt_pk_bf16(P1[2], P1[3]); w2_.z = cvt_pk_bf16(P1[4], P1[5]); w2_.w = cvt_pk_bf16(P1[6], P1[7]); \
        w3_.x = cvt_pk_bf16(P1[8], P1[9]); w3_.y = cvt_pk_bf16(P1[10], P1[11]); w3_.z = cvt_pk_bf16(P1[12], P1[13]); w3_.w = cvt_pk_bf16(P1[14], P1[15]); \
        pa0 = __builtin_bit_cast(bf16x8, w0_); pa1 = __builtin_bit_cast(bf16x8, w1_); pa2 = __builtin_bit_cast(bf16x8, w2_); pa3 = __builtin_bit_cast(bf16x8, w3_); } while (0)
#define ATT_QKEXP(PN0, PN1, CN, BOFF, PC0, PC1, CC) do { \
        __builtin_amdgcn_iglp_opt(1); \
        _Pragma("unroll") for (int r_ = 0; r_ < 16; ++r_) { PN0[r_] = -mrun[CN]; PN1[r_] = -mrun[CN]; } \
        const LAS unsigned char* kb_ = lds + (BOFF) + (KSH ? 0 : (CN)) * CK * 1024 + hi * 1024 + r32 * 16; \
        float ls_ = 0.f; unsigned w_[16]; \
        bf16x8 ka_[2], kc_[2], qf_[2];        \
        { int zo_ = 0; asm volatile("" : "+v"(zo_)); \
          ka_[0] = *(const LAS bf16x8*)(kb_ + zo_); kc_[0] = *(const LAS bf16x8*)(kb_ + zo_ + 512); \
          if constexpr (QLDS) qf_[0] = *(const LAS bf16x8*)(qlds + zo_ + ((CN) * KS) * 8192); else qf_[0] = qr[QLDS ? 0 : (CN)][0]; } \
        _Pragma("unroll") for (int d0_ = 0; d0_ < KS; ++d0_) { \
            if (d0_ + 1 < KS) { int zo_ = 0; asm volatile("" : "+v"(zo_)); \
                ka_[(d0_ + 1) & 1] = *(const LAS bf16x8*)(kb_ + zo_ + (d0_ + 1) * 2048); kc_[(d0_ + 1) & 1] = *(const LAS bf16x8*)(kb_ + zo_ + (d0_ + 1) * 2048 + 512); \
                if constexpr (QLDS) qf_[(d0_ + 1) & 1] = *(const LAS bf16x8*)(qlds + zo_ + ((CN) * KS + d0_ + 1) * 8192); else qf_[(d0_ + 1) & 1] = qr[QLDS ? 0 : (CN)][QLDS ? 0 : (d0_ + 1 < KS ? d0_ + 1 : 0)]; } \
            PN0 = __builtin_amdgcn_mfma_f32_32x32x16_bf16(ka_[d0_ & 1], qf_[d0_ & 1], PN0, 0, 0, 0); \
            PN1 = __builtin_amdgcn_mfma_f32_32x32x16_bf16(kc_[d0_ & 1], qf_[d0_ & 1], PN1, 0, 0, 0); \
            _Pragma("unroll") for (int r_ = ((16 * d0_ / KS) & ~1); r_ < (d0_ == KS - 1 ? 16 : ((16 * (d0_ + 1) / KS) & ~1)); r_ += 2) { \
                PC0[r_] = fast_exp2(PC0[r_]); PC0[r_ + 1] = fast_exp2(PC0[r_ + 1]); PC1[r_] = fast_exp2(PC1[r_]); PC1[r_ + 1] = fast_exp2(PC1[r_ + 1]); \
                ls_ += (PC0[r_] + PC0[r_ + 1]) + (PC1[r_] + PC1[r_ + 1]); \
                w_[r_ >> 1] = cvt_pk_bf16(PC0[r_], PC0[r_ + 1]); w_[8 + (r_ >> 1)] = cvt_pk_bf16(PC1[r_], PC1[r_ + 1]); } } \
        lrun[CC] += ls_; \
        pa0 = __builtin_bit_cast(bf16x8, (u32x4){w_[0], w_[1], w_[2], w_[3]}); pa1 = __builtin_bit_cast(bf16x8, (u32x4){w_[4], w_[5], w_[6], w_[7]}); \
        pa2 = __builtin_bit_cast(bf16x8, (u32x4){w_[8], w_[9], w_[10], w_[11]}); pa3 = __builtin_bit_cast(bf16x8, (u32x4){w_[12], w_[13], w_[14], w_[15]}); } while (0)
#define ATT_PV(C, BOFF) do { \
        const LAS unsigned char* vb_ = lds + (BOFF) + KBYTES + hi * DV * 16 + r32 * 16; \
        _Pragma("unroll") for (int d_ = 0; d_ < NDB; ++d_) { \
            o[C][d_] = __builtin_amdgcn_mfma_f32_32x32x16_bf16(pa0, *(const LAS bf16x8*)(vb_ + 0 * DV * 16 + d_ * 512), o[C][d_], 0, 0, 0); \
            o[C][d_] = __builtin_amdgcn_mfma_f32_32x32x16_bf16(pa1, *(const LAS bf16x8*)(vb_ + 2 * DV * 16 + d_ * 512), o[C][d_], 0, 0, 0); \
            o[C][d_] = __builtin_amdgcn_mfma_f32_32x32x16_bf16(pa2, *(const LAS bf16x8*)(vb_ + 4 * DV * 16 + d_ * 512), o[C][d_], 0, 0, 0); \
            o[C][d_] = __builtin_amdgcn_mfma_f32_32x32x16_bf16(pa3, *(const LAS bf16x8*)(vb_ + 6 * DV * 16 + d_ * 512), o[C][d_], 0, 0, 0); } } while (0)
    ATT_DMA(tlo, 0); ATT_DMA(tlo + 1, BUFB);
    ATT_SYNC();
    int bc = 0, bn = BUFB, bnn = 2 * BUFB;
    ATT_QK(pA0, pA1, 0, bc);
    if constexpr (NS == 1) {
        for (int t = tlo; t < thi; t += 2) {
            if (t + 2 < thi) ATT_DMA(t + 2, bnn);
            ATT_MAX(pA0, pA1, 0, t == tlo);
            ATT_QKEXP(pB0, pB1, 0, bn, pA0, pA1, 0);
            ATT_PV(0, bc);
            ATT_SYNC();
            if (t + 3 < thi) ATT_DMA(t + 3, bc);
            ATT_MAX(pB0, pB1, 0, false);
            ATT_QKEXP(pA0, pA1, 0, bnn, pB0, pB1, 0);
            ATT_PV(0, bn);
            ATT_SYNC();
            const int tmp = bc; bc = bnn; bnn = bn; bn = tmp;
        }
    } else if constexpr (NS == 3) {
        for (int t = tlo; t < thi; t += 2) {
            const bool first = (t == tlo);
            if (t + 2 < thi) ATT_DMA(t + 2, bnn);
            ATT_MAX(pA0, pA1, 0, first); ATT_QKEXP(pB0, pB1, 1, bc, pA0, pA1, 0); ATT_PV(0, bc);
            ATT_MAX(pB0, pB1, 1, first); ATT_QKEXP(pA0, pA1, NS - 1, bc, pB0, pB1, 1); ATT_PV(1, bc);
            ATT_MAX(pA0, pA1, NS - 1, first); ATT_QKEXP(pB0, pB1, 0, bn, pA0, pA1, NS - 1); ATT_PV(NS - 1, bc);
            ATT_SYNC();
            if (t + 3 < thi) ATT_DMA(t + 3, bc);
            ATT_MAX(pB0, pB1, 0, false); ATT_QKEXP(pA0, pA1, 1, bn, pB0, pB1, 0); ATT_PV(0, bn);
            ATT_MAX(pA0, pA1, 1, false); ATT_QKEXP(pB0, pB1, NS - 1, bn, pA0, pA1, 1); ATT_PV(1, bn);
            ATT_MAX(pB0, pB1, NS - 1, false); ATT_QKEXP(pA0, pA1, 0, bnn, pB0, pB1, NS - 1); ATT_PV(NS - 1, bn);
            ATT_SYNC();
            const int tmp = bc; bc = bnn; bnn = bn; bn = tmp;
        }
    } else {
        for (int t = tlo; t < thi; ++t) {
            if (t + 2 < thi) ATT_DMA(t + 2, bnn);
            ATT_MAX(pA0, pA1, 0, t == tlo);
            ATT_QKEXP(pB0, pB1, NS - 1, bc, pA0, pA1, 0);
            ATT_PV(0, bc);
            ATT_MAX(pB0, pB1, NS - 1, t == tlo);
            ATT_QKEXP(pA0, pA1, 0, bn, pB0, pB1, NS - 1);
            ATT_PV(NS - 1, bc);
            ATT_SYNC();
            const int tmp = bc; bc = bn; bn = bnn; bnn = tmp;
        }
    }
#undef ATT_DMA
#undef ATT_SYNC
#undef ATT_QK
#undef ATT_MAX
#undef ATT_EXP
#undef ATT_PV
#undef ATT_QKEXP
    float rl[NS][16];
#pragma unroll
    for (int c = 0; c < NS; ++c) {
        const float lt = xadd32(lrun[c]);
        if (hi == 0) wsf[r32] = fast_rcp(lt);
        asm volatile("s_waitcnt lgkmcnt(0)" ::: "memory");
#pragma unroll
        for (int r = 0; r < 16; ++r) rl[c][r] = wsf[crow(r, hi)];
        asm volatile("s_waitcnt lgkmcnt(0)" ::: "memory");
    }
    constexpr int NOUT = KSH ? NS * DV : DV;
    LAS bf16_t* stg = (LAS bf16_t*)(lds + (QLDS ? 3 * BUFB + 2048 : 0) + wid * (32 * NOUT * 2));
    if constexpr (KSH) {
#pragma unroll
        for (int c = 0; c < NS; ++c)
#pragma unroll
        for (int d = 0; d < NDB; ++d)
#pragma unroll
            for (int r = 0; r < 16; ++r) {
                const float v = o[c][d][r] * rl[c][r];
                stg[crow(r, hi) * NOUT + c * DV + d * 32 + r32] = (bf16_t)(cvt_pk_bf16(v, 0.f) & 0xffffu);
            }
    } else {
        float ss[16];
#pragma unroll
        for (int r = 0; r < 16; ++r) ss[r] = 0.f;
#pragma unroll
        for (int d = 0; d < NDB; ++d)
#pragma unroll
            for (int r = 0; r < 16; ++r) { const float v = o[0][d][r] * rl[0][r] - lam * (o[1][d][r] * rl[1][r]); o[0][d][r] = v; ss[r] += v * v; }
#pragma unroll
        for (int r = 0; r < 16; ++r) {
            ss[r] = sum32(ss[r]);
            ss[r] = __builtin_amdgcn_rsqf(ss[r] * (1.0f / DV) + EPS) * outscale;
        }
#pragma unroll
        for (int d = 0; d < NDB; ++d) {
            const float g = gsub[d * 32 + r32];
#pragma unroll
            for (int r = 0; r < 16; ++r) {
                const float v = o[0][d][r] * ss[r] * g;
                stg[crow(r, hi) * NOUT + d * 32 + r32] = (bf16_t)(cvt_pk_bf16(v, 0.f) & 0xffffu);
            }
        }
    }
    asm volatile("s_waitcnt lgkmcnt(0)" ::: "memory");
    {
        constexpr int CPR = NOUT / 8;
        constexpr int NIT = 32 * CPR / 64;
#pragma unroll
        for (int i = 0; i < NIT; ++i) {
            const int idx = i * 64 + lane; const int row = idx / CPR, ch = idx % CPR;
            const u32x4 v = *(const LAS u32x4*)(stg + row * NOUT + ch * 8);
            *(u32x4*)(Y + (size_t)(qrow0 + wid * 32 + row) * DM + ch * 8) = v;
        }
    }
}

__device__ __forceinline__ void bmix_unit(LAS unsigned char* lds, const bf16_t* U, const bf16_t* VG, const float* gv  , const float* ws  , const float* bs  ,
                                          int ci, int g, bf16_t* Y) {
    const int tid = opaque_tid(), lane = tid & 63, r32 = lane & 31, hi = lane >> 5; const int wid = __builtin_amdgcn_readfirstlane(tid >> 6);
    const int r0 = ci * 128;
    LAS float* rstd = (LAS float*)lds;
    LAS bf16_t* vnT = (LAS bf16_t*)(lds + 512);
    {
        const int q = tid >> 2, part = tid & 3; float ss = 0.f;
        const bf16_t* p = VG + (size_t)(r0 + q) * 256 + part * 64;
#pragma unroll
        for (int i = 0; i < 8; ++i) { const u32x4 w = *(const u32x4*)(p + 8 * i);
#pragma unroll
            for (int e = 0; e < 4; ++e) { const float lo = __uint_as_float(w[e] << 16), hi2 = __uint_as_float(w[e] & 0xffff0000u); ss += lo * lo + hi2 * hi2; } }
        ss += swz_xor<1>(ss); ss += swz_xor<2>(ss);
        if (part == 0) rstd[q] = __builtin_amdgcn_rsqf(ss * (1.0f / 256.0f) + EPS);
    }
    __syncthreads();
#pragma unroll
    for (int i = 0; i < 2; ++i) {
        const int idx = tid + i * NTHREADS; const int q = idx >> 3, c8 = idx & 7;
        const u32x4 w = *(const u32x4*)(VG + (size_t)(r0 + q) * 256 + g * 64 + c8 * 8); const float rs = rstd[q];
#pragma unroll
        for (int e = 0; e < 4; ++e) {
            const float lo = __uint_as_float(w[e] << 16) * rs * gv[g * 64 + c8 * 8 + 2 * e], hi2 = __uint_as_float(w[e] & 0xffff0000u) * rs * gv[g * 64 + c8 * 8 + 2 * e + 1];
            const unsigned pk = cvt_pk_bf16(lo, hi2);
            vnT[(c8 * 8 + 2 * e) * 136 + q] = (bf16_t)(pk & 0xffffu); vnT[(c8 * 8 + 2 * e + 1) * 136 + q] = (bf16_t)(pk >> 16);
        }
    }
    __syncthreads();
    const int pblk = wid & 3, cblk = wid >> 2;
    f32x16 acc;
#pragma unroll
    for (int r = 0; r < 16; ++r) acc[r] = 0.f;
    const float* wrow = ws + ((size_t)g * 128 + pblk * 32 + r32) * 128 + hi * 8;
#pragma unroll
    for (int ks = 0; ks < 8; ++ks) {
        const f32x4 a0 = *(const f32x4*)(wrow + ks * 16), a1 = *(const f32x4*)(wrow + ks * 16 + 4);
        u32x4 aw; aw.x = cvt_pk_bf16(a0[0], a0[1]); aw.y = cvt_pk_bf16(a0[2], a0[3]); aw.z = cvt_pk_bf16(a1[0], a1[1]); aw.w = cvt_pk_bf16(a1[2], a1[3]);
        const bf16x8 bfr = *(const LAS bf16x8*)(vnT + (cblk * 32 + r32) * 136 + ks * 16 + hi * 8);
        acc = __builtin_amdgcn_mfma_f32_32x32x16_bf16(__builtin_bit_cast(bf16x8, aw), bfr, acc, 0, 0, 0);
    }
#pragma unroll
    for (int r = 0; r < 16; ++r) {
        const int p = pblk * 32 + crow(r, hi); const int col = g * 64 + cblk * 32 + r32;
        const float mixed = acc[r] + bs[g * 128 + p];
        const float uu = bf2f(U[(size_t)(r0 + p) * 256 + col]);
        Y[(size_t)(r0 + p) * DM + 384 + col] = (bf16_t)(cvt_pk_bf16(uu * mixed, 0.f) & 0xffffu);
    }
    __syncthreads();
}

__device__ __forceinline__ void mixer_phase(const Args& a, LAS unsigned char* lds, int l, unsigned* ctr) {
    const bool last = (l == DEPTH - 1);
    unsigned char* mx = a.ws + WS_ACT;
    bf16_t* Y = (bf16_t*)(a.ws + WS_H);
    const bf16_t* QA = (const bf16_t*)(mx + MX_QA); const bf16_t* KA = (const bf16_t*)(mx + MX_KA);
    const bf16_t* QC = (const bf16_t*)(mx + MX_QC); const bf16_t* KC = (const bf16_t*)(mx + MX_KC);
    const bf16_t* VT = (const bf16_t*)(mx + MX_VT);
    const int nC = 512, nA = 512, nCc = last ? 0 : 16, nAc = last ? 0 : 16, nB = last ? 1024 : 1056;
    const int total = nC + nA + nCc + nAc + nB;
    const float* lv = a.in[I_LAM] + l * 4 * 48;
    float d1 = 0.f, d2 = 0.f;
    for (int i = 0; i < 48; ++i) { d1 += lv[i] * lv[48 + i]; d2 += lv[96 + i] * lv[144 + i]; }
    const float lam_init = 0.8f - 0.6f * expf(-0.3f * (float)l);
    const float lam = expf(d1) - expf(d2) + lam_init;
    LAS unsigned* sidx = (LAS unsigned*)(lds + LDS_MISC + 64);
    for (;;) {
        if (opaque_tid() == 0) *sidx = atomicAdd(ctr, 1u);
        __syncthreads();
        const int idx = (int)*sidx;
        __syncthreads();
        if (idx >= total) break;
        int j = idx;
        if (j < nC) {
            const int b = j >> 7, h = (j >> 5) & 3, qb = j & 31;
            attn_unit<2, 48, 96, false>(lds, QC + (size_t)h * R * 48, KC + (size_t)h * R * 48, 4 * R * 48, VT + (size_t)(128 + h * 96) * R, b * SEQ + qb * 256, b, 0, 132, Y + 640 + h * 96, lam, a.in[I_GSUB] + l * 96, 1.0f - lam_init);
            continue;
        }
        j -= nC;
        if (j < nA) {
            const int pair = j < 256; const int jj = j & 255; const int b = jj >> 6, hkv = (jj >> 5) & 1, qb = jj & 31;
            if (pair) attn_unit<2, 64, 64, true>(lds, QA + (size_t)(hkv * 3) * R * 64, KA + (size_t)hkv * R * 64, R * 64, VT + (size_t)(hkv * 64) * R, b * SEQ + qb * 256, b, 0, 132, Y + hkv * 192, 0.f, nullptr, 1.0f);
            else attn_unit<1, 64, 64, true>(lds, QA + (size_t)(hkv * 3 + 2) * R * 64, KA + (size_t)hkv * R * 64, 0, VT + (size_t)(hkv * 64) * R, b * SEQ + qb * 256, b, 0, 132, Y + hkv * 192 + 128, 0.f, nullptr, 1.0f);
            continue;
        }
        j -= nA;
        if (j < nCc) {
            const int b = j >> 2, h = j & 3;
            attn_unit<2, 48, 96, false>(lds, QC + (size_t)h * R * 48, KC + (size_t)h * R * 48, 4 * R * 48, VT + (size_t)(128 + h * 96) * R, RL + b * CTXL, b, 128, 132, Y + 640 + h * 96, lam, a.in[I_GSUB] + l * 96, 1.0f - lam_init);
            continue;
        }
        j -= nCc;
        if (j < nAc) {
            const int pair = j < 8; const int jj = j & 7; const int b = jj >> 1, hkv = jj & 1;
            if (pair) attn_unit<2, 64, 64, true>(lds, QA + (size_t)(hkv * 3) * R * 64, KA + (size_t)hkv * R * 64, R * 64, VT + (size_t)(hkv * 64) * R, RL + b * CTXL, b, 128, 132, Y + hkv * 192, 0.f, nullptr, 1.0f);
            else attn_unit<1, 64, 64, true>(lds, QA + (size_t)(hkv * 3 + 2) * R * 64, KA + (size_t)hkv * R * 64, 0, VT + (size_t)(hkv * 64) * R, RL + b * CTXL, b, 128, 132, Y + hkv * 192 + 128, 0.f, nullptr, 1.0f);
            continue;
        }
        j -= nAc;
        bmix_unit(lds, (const bf16_t*)(mx + MX_U), (const bf16_t*)(mx + MX_VG), a.in[I_GV] + l * 256, a.in[I_WS] + (size_t)l * 4 * 128 * 128, a.in[I_BS] + l * 4 * 128, j >> 2, j & 3, Y);
    }
}

__global__ void __launch_bounds__(NTHREADS, 2) fwd_megakernel(Args a) {
    extern __shared__ __attribute__((aligned(16))) unsigned char lds_raw[];
    LAS unsigned char* lds = (LAS unsigned char*)lds_raw;
    const int tid = threadIdx.x, lane = tid & 63; const int wave = __builtin_amdgcn_readfirstlane(tid >> 6);
    const int G = gridDim.x, bx = blockIdx.x;
    volatile LAS unsigned* MISC = (volatile LAS unsigned*)(lds + LDS_MISC);
    if (tid < 64) MISC[tid] = 0u;
    __syncthreads();
    unsigned* ctl = (unsigned*)(a.ws + WS_CTL);
    XcdBarrier bar = xcd_barrier_post(ctl + 4096, MISC + 8);
    unsigned* qctr = ctl + 16384;

    phase0(a, lds, tid, lane, wave);
    cg::this_grid().sync();

    float* xres = (float*)(a.ws + WS_XRES);
    bf16_t* H = (bf16_t*)(a.ws + WS_H);
    bf16_t* ACT = (bf16_t*)(a.ws + WS_ACT);
    const float* modv = (const float*)(a.ws + WS_MODV);
    float* part = (float*)(a.ws + WS_PART);
#pragma unroll 1
    for (int l = 0; l < DEPTH; ++l) {
        const bool last = (l == DEPTH - 1);
        const float* modl = modv + (size_t)l * 5 * 9216;
        unsigned char* wl = a.ws + WS_W + (size_t)l * LAYER_W_BYTES;
        const float* xL = (l == 0) ? a.in[I_X] : xres;
        const float* xC = (l == 0) ? a.in[I_CTX] : xres + (size_t)RL * DM;
        norm_phase(xL, xC, a.in[I_GFFN1] + l * DM, modl, 0, H, R, part, l == 0 ? 0 : 11, modl - 5 * 9216 + 4 * 9216 + 8 * 1024, 0.5f, xres + (size_t)RL * DM);
        xcd_barrier(bar);
        { pg8::SchedOne S{(const char*)H, (const char*)(wl + W_1IN), 132, 22, G, bx, (size_t)256 * 1024 * 2, 16}; pg8::EpiUp E{ACT};
          pg8::gemm_phase<pg8::EpiUp, pg8::SchedOne>(lds, 1024, S, E); }
        xcd_barrier(bar);
        { pg8::SchedDown S{(const char*)ACT, (const char*)(wl + W_1OUT), G, bx, (size_t)256 * FF * 2, 44, 4, 11, 4}; pg8::EpiDown E{xL, xres + (size_t)RL * DM, xres, modl + 2 * 1024, 0.5f, part};
          pg8::gemm_phase<pg8::EpiDown, pg8::SchedDown>(lds, FF, S, E); }
        xcd_barrier(bar);
        norm_phase(xres, xres + (size_t)RL * DM, a.in[I_GMIX] + l * DM, modl, 3, H, R, part, 11, modl + 4 * 9216 + 2 * 1024, 0.5f, xres + (size_t)RL * DM);
        xcd_barrier(bar);
        { pg8::SchedMix S{(const char*)H, (const char*)(wl + W_MIX), (const char*)(wl + W_MIX) + (size_t)1792 * 1024 * 2, G, bx, (size_t)256 * 1024 * 2};
          pg8::EpiMix E{a.ws + WS_ACT, (const float*)(a.ws + WS_GTAB) + l * 128, (const float*)(a.ws + WS_GTAB) + l * 128 + 64};
          pg8::gemm_phase<pg8::EpiMix, pg8::SchedMix>(lds, 1024, S, E); }
        xcd_barrier(bar);
        mixer_phase(a, lds, l, qctr + 64 * l);
        xcd_barrier(bar);
        { pg8::SchedDown S{(const char*)H, (const char*)(wl + W_OUT), G, bx, (size_t)256 * 1024 * 2, 16, last ? 0 : 4, 4, 4}; pg8::EpiDown E{xres, xres + (size_t)RL * DM, xres, modl + 5 * 1024, 1.0f, part};
          pg8::gemm_phase<pg8::EpiDown, pg8::SchedDown>(lds, 1024, S, E); }
        xcd_barrier(bar);
        norm_phase(xres, xres + (size_t)RL * DM, a.in[I_GFFN2] + l * DM, modl, 6, H, last ? RL : R, part, 4, modl + 4 * 9216 + 5 * 1024, 1.0f, xres + (size_t)RL * DM);
        xcd_barrier(bar);
        { pg8::SchedOne S{(const char*)H, (const char*)(wl + W_2IN), last ? 128 : 132, 22, G, bx, (size_t)256 * 1024 * 2, 16}; pg8::EpiUp E{ACT};
          pg8::gemm_phase<pg8::EpiUp, pg8::SchedOne>(lds, 1024, S, E); }
        xcd_barrier(bar);
        { pg8::SchedDown S{(const char*)ACT, (const char*)(wl + W_2OUT), G, bx, (size_t)256 * FF * 2, 44, last ? 0 : 4, 11, 4}; pg8::EpiDown E{xres, xres + (size_t)RL * DM, xres, modl + 8 * 1024, 0.5f, part};
          pg8::gemm_phase<pg8::EpiDown, pg8::SchedDown>(lds, FF, S, E); }
        xcd_barrier(bar);
    }
    final_phase(xres, a.in[I_GFINAL], a.out);
}

extern "C" void kernel_launch(void* const* d_in, const int* in_sizes, int n_in, void* d_out, int out_size, void* d_ws, size_t ws_size, hipStream_t stream) {
    static int grid = 0;
    if (grid == 0) {
        if (n_in != 23 || ws_size < WS_END) { fprintf(stderr, "kernel_launch: n_in %d ws %zu (need %zu)\n", n_in, ws_size, (size_t)WS_END); grid = -1; return; }
        int dev = 0, cus = 0, per_cu = 0;
        hipGetDevice(&dev); hipDeviceGetAttribute(&cus, hipDeviceAttributeMultiprocessorCount, dev);
        hipFuncSetAttribute((const void*)fwd_megakernel, hipFuncAttributeMaxDynamicSharedMemorySize, LDS_BYTES);
        hipOccupancyMaxActiveBlocksPerMultiprocessor(&per_cu, (const void*)fwd_megakernel, NTHREADS, LDS_BYTES);
        (void)hipGetLastError();
        if (per_cu < 1) { fprintf(stderr, "kernel_launch: occupancy query says %d blocks per CU\n", per_cu); per_cu = 1; }
        grid = cus;
    }
    if (grid < 0) return;
    hipMemsetAsync((char*)d_ws + WS_CTL, 0, 1 * MiB, stream);
    Args a{};
    for (int i = 0; i < 23; ++i) a.in[i] = (const float*)d_in[i];
    a.out = (float*)d_out; a.ws = (unsigned char*)d_ws;
    void* args[] = {&a};
    hipError_t e = hipLaunchCooperativeKernel((const void*)fwd_megakernel, dim3(grid), dim3(NTHREADS), args, LDS_BYTES, stream);
    if (e != hipSuccess) fprintf(stderr, "cooperative launch failed: %s (grid %d)\n", hipGetErrorString(e), grid);
}
```

```cpp
#include <hip/hip_runtime.h>
#include <hip/hip_cooperative_groups.h>
#include <cstdio>
#include <cstdint>
namespace cg = cooperative_groups;

#define LAS __attribute__((address_space(3)))
typedef unsigned short bf16_t;
typedef short bf16x8 __attribute__((ext_vector_type(8)));
typedef float f32x4 __attribute__((ext_vector_type(4)));
typedef float f32x2 __attribute__((ext_vector_type(2)));
typedef float f32x16 __attribute__((ext_vector_type(16)));
typedef unsigned u32x4 __attribute__((ext_vector_type(4)));
typedef unsigned u32x2 __attribute__((ext_vector_type(2)));

constexpr int DM = 1024, NB = 4, SEQ = 8192, DEPTH = 4, CTXL = 256, FF = 2816, NMOD = 9;
constexpr int RL = NB * SEQ;
constexpr int RC = NB * CTXL;
constexpr int R = RL + RC;
constexpr int INW = 2304;
constexpr float EPS = 1e-6f;
constexpr float LOG2E = 1.4426950408889634f;
constexpr int NTHREADS = 512, NWAVES = 8;

constexpr size_t MiB = 1u << 20;
constexpr size_t WS_CTL = 0;
constexpr size_t WS_MODV = 1 * MiB;
constexpr size_t WS_GTAB = WS_MODV + 768 * 1024;
constexpr size_t WS_W = 2 * MiB;
constexpr size_t W_1IN = 0;
constexpr size_t W_1OUT = W_1IN + (size_t)5632 * 1024 * 2;
constexpr size_t W_MIX = W_1OUT + (size_t)1024 * 2816 * 2;
constexpr size_t W_OUT = W_MIX + (size_t)2304 * 1024 * 2;
constexpr size_t W_2IN = W_OUT + (size_t)1024 * 1024 * 2;
constexpr size_t W_2OUT = W_2IN + (size_t)5632 * 1024 * 2;
constexpr size_t LAYER_W_BYTES = W_2OUT + (size_t)1024 * 2816 * 2;
constexpr size_t WS_XRES = WS_W + DEPTH * LAYER_W_BYTES;
constexpr size_t WS_H = WS_XRES + (size_t)R * DM * 4;
constexpr size_t WS_ACT = WS_H + (size_t)R * DM * 2;
constexpr size_t WS_PART = WS_ACT + (size_t)R * FF * 2;
constexpr size_t WS_END = WS_PART + (size_t)11 * RC * DM * 4;
constexpr size_t MX_QA = 0;
constexpr size_t MX_KA = MX_QA + (size_t)6 * R * 64 * 2;
constexpr size_t MX_QC = MX_KA + (size_t)2 * R * 64 * 2;
constexpr size_t MX_KC = MX_QC + (size_t)8 * R * 48 * 2;
constexpr size_t MX_U = MX_KC + (size_t)8 * R * 48 * 2;
constexpr size_t MX_VG = MX_U + (size_t)R * 256 * 2;
constexpr size_t MX_VT = MX_VG + (size_t)R * 256 * 2;
static_assert(MX_VT + (size_t)512 * R * 2 <= (size_t)R * FF * 2, "mixer overlay fits");

constexpr int LDS_MAIN = 131072;
constexpr int LDS_MISC = LDS_MAIN;
constexpr int LDS_BYTES = LDS_MAIN + 256;

typedef __bf16 bf16x2_t __attribute__((ext_vector_type(2)));
__device__ __forceinline__ unsigned cvt_pk_bf16(float lo, float hi) { const f32x2 v = {lo, hi}; const bf16x2_t b = __builtin_convertvector(v, bf16x2_t); return __builtin_bit_cast(unsigned, b); }
__device__ __forceinline__ float bf2f(bf16_t v) { return __uint_as_float(((unsigned)v) << 16); }
__device__ __forceinline__ float fast_exp2(float x) { return __builtin_amdgcn_exp2f(x); }
__device__ __forceinline__ float fast_rcp(float x) { return __builtin_amdgcn_rcpf(x); }
__device__ __forceinline__ float silu_f(float x) { return x * fast_rcp(1.0f + fast_exp2(-x * LOG2E)); }
__device__ __forceinline__ float gelu_tanh_f(float x) { const float u = 0.7978845608028654f * (x + 0.044715f * x * x * x); return x * fast_rcp(1.0f + fast_exp2(-2.0f * LOG2E * u)); }
template <int M> __device__ __forceinline__ float swz_xor(float v) { return __builtin_bit_cast(float, __builtin_amdgcn_ds_swizzle(__builtin_bit_cast(int, v), (M << 10) | 0x1f)); }
__device__ __forceinline__ float max3f(float a, float b, float c) { return __builtin_elementwise_maximum(__builtin_elementwise_maximum(a, b), c); }
__device__ __forceinline__ float xadd32(float v) { auto rr = __builtin_amdgcn_permlane32_swap(__float_as_uint(v), __float_as_uint(v), false, false); return __uint_as_float(rr[0]) + __uint_as_float(rr[1]); }
__device__ __forceinline__ float xmax32(float v) { auto rr = __builtin_amdgcn_permlane32_swap(__float_as_uint(v), __float_as_uint(v), false, false); const float a = __uint_as_float(rr[0]), b = __uint_as_float(rr[1]); return max3f(a, b, b); }
__device__ __forceinline__ float sum32(float v) { v += swz_xor<1>(v); v += swz_xor<2>(v); v += swz_xor<4>(v); v += swz_xor<8>(v); v += swz_xor<16>(v); return v; }
__device__ __forceinline__ float wave_sum(float v) { return xadd32(sum32(v)); }
__device__ __forceinline__ int opaque_tid() { int t = threadIdx.x; asm volatile("" : "+v"(t)); return t; }
__device__ __forceinline__ int crow(int r, int hi) { return (r & 3) + 8 * (r >> 2) + 4 * hi; }

#define XB_TMO      128
#define XB_XCNT(j)  (256  + 64 * (j))
#define XB_XSUB(j)  (1280 + 64 * (j))
#define XB_XGEN(j)  (2304 + 64 * (j))
#define XB_TOP      3328
#define XB_TOPGEN   3392
#define XCD_BAR_WORDS 3456
#define XB_SPIN_CAP (1u << 22)
__device__ __forceinline__ unsigned xb_ld(unsigned* p)              { return __hip_atomic_load(p, __ATOMIC_RELAXED, __HIP_MEMORY_SCOPE_AGENT); }
__device__ __forceinline__ unsigned xb_add(unsigned* p, unsigned v) { return __hip_atomic_fetch_add(p, v, __ATOMIC_RELAXED, __HIP_MEMORY_SCOPE_AGENT); }
__device__ __forceinline__ unsigned xb_xcc_id() { return (unsigned)__builtin_amdgcn_s_getreg((3 << 11) | 20) & 0xFu; }
#define XB_SPIN(cond, bar) do { unsigned _sp = 0; while (cond) { __builtin_amdgcn_s_sleep(1); \
    if ((++_sp & 255u) == 0u) { if (xb_ld(&(bar)[XB_TMO])) break; if (_sp > XB_SPIN_CAP) { atomicAdd(&(bar)[XB_TMO], 1u); break; } } } } while (0)
struct XcdBarrier { unsigned* bar; unsigned x; volatile LAS unsigned* st; };
__device__ __forceinline__ XcdBarrier xcd_barrier_post(unsigned* bar, volatile LAS unsigned* st) {
    XcdBarrier b; b.bar = bar; b.x = xb_xcc_id(); b.st = st;
    if (threadIdx.x == 0) (void)xb_add(&bar[XB_XCNT(b.x)], 1u);
    return b;
}
__device__ __forceinline__ void xcd_barrier_complete(unsigned* bar, unsigned x, unsigned& nloc, unsigned& nx) {
    const unsigned G = gridDim.x * gridDim.y * gridDim.z;
    unsigned sum, cnt, mine, sp = 0u;
    for (;;) {
        sum = 0u; cnt = 0u; mine = 0u;
#pragma unroll
        for (unsigned j = 0; j < 16; ++j) { const unsigned c = xb_ld(&bar[XB_XCNT(j)]); sum += c; cnt += (c > 0u) ? 1u : 0u; mine = (j == x) ? c : mine; }
        if (sum == G) break;
        __builtin_amdgcn_s_sleep(1);
        if ((++sp & 255u) == 0u) { if (xb_ld(&bar[XB_TMO])) break; if (sp > XB_SPIN_CAP) { atomicAdd(&bar[XB_TMO], 1u); break; } }
    }
    nloc = mine > 0u ? mine : 1u; nx = cnt > 0u ? cnt : 1u;
}
__device__ __forceinline__ void xcd_barrier(const XcdBarrier& b) {
    asm volatile("s_waitcnt vmcnt(0)" ::: "memory");
    __syncthreads();
    if (opaque_tid() == 0) {
        unsigned* bar = b.bar;
        __builtin_amdgcn_s_waitcnt(0);
        unsigned nloc = b.st[0], nx = b.st[1];
        if (nloc == 0u) { xcd_barrier_complete(bar, b.x, nloc, nx); b.st[0] = nloc; b.st[1] = nx; }
        const unsigned old = xb_add(&bar[XB_XSUB(b.x)], 1u);
        const unsigned gen = old / nloc;
        if (old + 1u == (gen + 1u) * nloc) {
            __builtin_amdgcn_fence(__ATOMIC_RELEASE, "agent");
            asm volatile("s_waitcnt vmcnt(0)" ::: "memory");
            const unsigned og = xb_add(&bar[XB_TOP], 1u);
            const unsigned tg = og / nx;
            if (og + 1u == (tg + 1u) * nx) xb_add(&bar[XB_TOPGEN], 1u);
            else XB_SPIN(xb_ld(&bar[XB_TOPGEN]) == tg, bar);
            __builtin_amdgcn_fence(__ATOMIC_ACQUIRE, "agent");
            xb_add(&bar[XB_XGEN(b.x)], 1u);
            asm volatile("s_waitcnt vmcnt(0)" ::: "memory");
        } else {
            XB_SPIN(xb_ld(&bar[XB_XGEN(b.x)]) == gen, bar);
            __builtin_amdgcn_fence(__ATOMIC_ACQUIRE, "agent");
            asm volatile("s_waitcnt vmcnt(0)" ::: "memory");
        }
    }
    __syncthreads();
}

namespace pg8 {
constexpr int BM = 256, BK = 64, HALF = 128, HTB = HALF * BK * 2, STAGE_BYTES = 8 * HTB, NXCD = 8, WGM = 8;
__device__ __forceinline__ int lds_byte(int r, int c) { const int st = (r >> 4) * 2 + (c >> 5), rr = r & 15, cc = c & 31, ob = rr * 64 + cc * 2; return st * 1024 + (ob ^ (((ob >> 9) & 1) << 5)); }
__device__ __forceinline__ void stage_rc(int b, int& Rr, int& C) { const int st = b / 1024, sb = b % 1024, swz = sb ^ (((sb >> 9) & 1) << 5); Rr = (st >> 1) * 16 + swz / 64; C = (st & 1) * 32 + (swz % 64) / 2; }
__device__ __forceinline__ int perm32(int rho) { const int n = rho >> 4, i = rho & 15; return 8 * (i >> 2) + 4 * n + (i & 3); }

struct Unit { const char* a; const char* b; int pm, pn, kind, nt; };

__device__ __forceinline__ void order_map(int L, int nM, int nN, int& pm, int& pn) {
    const int nwg = nM * nN; int wgid = L;
    { const int q = nwg / NXCD, r = nwg % NXCD, xcd = wgid % NXCD, off = wgid / NXCD; wgid = (xcd < r ? xcd * (q + 1) : r * (q + 1) + (xcd - r) * q) + off; }
    const int nig = WGM * nN, gid = wgid / nig, fm = gid * WGM, gsz = (nM - fm) < WGM ? (nM - fm) : WGM;
    pm = fm + ((wgid % nig) % gsz); pn = (wgid % nig) / gsz;
}
struct SchedOne {
    const char* A; const char* B; int nM, nN, G, c; size_t tstep; int nt;
    __device__ __forceinline__ bool next(int i, Unit& u) const {
        const long L = (long)i * G + c; if (L >= (long)nM * nN) return false;
        int pm, pn; order_map((int)L, nM, nN, pm, pn);
        u.pm = pm; u.pn = pn; u.kind = 0; u.nt = nt; u.a = A + (size_t)pm * tstep; u.b = B + (size_t)pn * tstep; return true;
    }
};
struct SchedDown {
    const char* A; const char* B; int G, c; size_t tstep; int nt, nctx, nsplit, ntc;
    __device__ __forceinline__ bool next(int i, Unit& u) const {
        const long L = (long)i * G + c; constexpr int n1 = 128 * 4; const int nsub = nctx * 4 * nsplit;
        if (L >= n1 + nsub) return false;
        int pm, pn;
        if (L >= nsub) { order_map((int)L - nsub, 128, 4, pm, pn); u.kind = 0; u.nt = nt; u.a = A + (size_t)pm * tstep; u.b = B + (size_t)pn * tstep; }
        else { const int j = (int)L, ks = j % nsplit, tile = j / nsplit; pm = 128 + (tile >> 2); pn = tile & 3; u.kind = 1 + ks; u.nt = ntc;
               u.a = A + (size_t)pm * tstep + (size_t)ks * ntc * 128; u.b = B + (size_t)pn * tstep + (size_t)ks * ntc * 128; }
        u.pm = pm; u.pn = pn; return true;
    }
};
struct SchedMix {
    const char* H; const char* Wm; const char* Wv; int G, c; size_t tstep;
    __device__ __forceinline__ bool next(int i, Unit& u) const {
        const long L = (long)i * G + c; constexpr int n1 = 132 * 7, n2 = 2 * 132;
        if (L >= n1 + n2) return false;
        int pm, pn;
        if (L < n1) { order_map((int)L, 132, 7, pm, pn); u.kind = 0; u.nt = 16; u.a = H + (size_t)pm * tstep; u.b = Wm + (size_t)pn * tstep; }
        else { order_map((int)L - n1, 2, 132, pm, pn); u.kind = 1; u.nt = 16; u.a = Wv + (size_t)pm * tstep; u.b = H + (size_t)pn * tstep; }
        u.pm = pm; u.pn = pn; return true;
    }
};

template <class Epi, class Sched, bool ALIGN_EPI = true, bool SP2 = true>
__device__ __forceinline__ void gemm_phase(LAS unsigned char* lds, const int K, const Sched& S, const Epi& E) {
    const int tid = opaque_tid(), wid = __builtin_amdgcn_readfirstlane(tid >> 6), lane = tid & 63, wr = wid >> 2, wc = wid & 3, fr = lane & 15, fq = lane >> 4;
    unsigned voffA[2], voffB[2];
#pragma unroll
    for (int i = 0; i < 2; ++i) { int Rr, C; stage_rc(tid * 16 + i * 8192, Rr, C); const int Rb = Epi::PERM ? ((Rr & ~31) + perm32(Rr & 31)) : Rr;
        voffA[i] = (unsigned)(Rr * K + C) * 2u; voffB[i] = (unsigned)(Rb * K + C) * 2u; }
    const size_t kstep = (size_t)(BK * 2);
    const size_t hstep = (size_t)HALF * K * 2;
    const unsigned ldsw = (unsigned)wid * 1024u;
    const int aoff = lds_byte(wr * 64 + fr, fq * 8), boff = lds_byte(wc * 32 + fr, fq * 8);
#define PG8_SA(b, h) (((b) * 2 + (h)) * HTB)
#define PG8_SB(b, h) ((4 + (b) * 2 + (h)) * HTB)
#define PG8_STAGE(bufoff, gbase, voff) do { _Pragma("unroll") for (int _i = 0; _i < 2; ++_i) \
        __builtin_amdgcn_global_load_lds((const unsigned*)((const char*)(gbase) + (voff)[_i]), (LAS unsigned*)(lds + (bufoff) + ldsw + _i * 8192), 16, 0, 0); } while (0)
#define PG8_LDA(dst, b, h) do { _Pragma("unroll") for (int m = 0; m < 4; ++m) _Pragma("unroll") for (int k = 0; k < 2; ++k) dst[m][k] = *(const LAS bf16x8*)(lds + PG8_SA(b, h) + aoff + m * 2048 + k * 1024); } while (0)
#define PG8_LDB(dst, b, h) do { _Pragma("unroll") for (int n = 0; n < 2; ++n) _Pragma("unroll") for (int k = 0; k < 2; ++k) dst[n][k] = *(const LAS bf16x8*)(lds + PG8_SB(b, h) + boff + n * 2048 + k * 1024); } while (0)
#define PG8_MMA(ai, bj, At, Bt) do { __builtin_amdgcn_s_setprio(1); _Pragma("unroll") for (int m = 0; m < 4; ++m) _Pragma("unroll") for (int n = 0; n < 2; ++n) _Pragma("unroll") for (int k = 0; k < 2; ++k) \
        acc[ai][bj][m][n] = __builtin_amdgcn_mfma_f32_16x16x32_bf16(Bt[n][k], At[m][k], acc[ai][bj][m][n], 0, 0, 0); __builtin_amdgcn_s_setprio(0); } while (0)
#define PG8_WAIT_V(n) asm volatile("s_waitcnt vmcnt(" #n ")" ::: "memory")
#define PG8_WAIT_L(n) asm volatile("s_waitcnt lgkmcnt(" #n ")" ::: "memory")
#define PG8_BAR __builtin_amdgcn_s_barrier()
#define PG8_SCHED __builtin_amdgcn_sched_barrier(0)
    Unit cur, nxt; int ui = 0;
    if (!S.next(0, cur)) return;
    f32x4 acc[2][2][4][2];
#pragma unroll
    for (int a = 0; a < 2; ++a)
#pragma unroll
        for (int b = 0; b < 2; ++b)
#pragma unroll
            for (int m = 0; m < 4; ++m)
#pragma unroll
                for (int n = 0; n < 2; ++n) acc[a][b][m][n] = (f32x4){0.f, 0.f, 0.f, 0.f};
    bf16x8 At[4][2], B0[2][2], B1[2][2];
    const char* cA = cur.a; const char* cB = cur.b;
    if constexpr (SP2) {
        PG8_STAGE(PG8_SB(0, 0), cB, voffB); PG8_STAGE(PG8_SB(0, 1), cB + hstep, voffB); PG8_STAGE(PG8_SA(0, 0), cA, voffA); PG8_STAGE(PG8_SA(0, 1), cA + hstep, voffA);
        if (wr == 1) PG8_BAR;
        PG8_WAIT_V(2); PG8_BAR;
        PG8_STAGE(PG8_SB(1, 0), cB + kstep, voffB); PG8_STAGE(PG8_SA(1, 0), cA + kstep, voffA); PG8_STAGE(PG8_SB(1, 1), cB + hstep + kstep, voffB);
        PG8_WAIT_V(6); PG8_BAR;
    } else {
        PG8_STAGE(PG8_SB(0, 0), cB, voffB); PG8_STAGE(PG8_SA(0, 0), cA, voffA); PG8_STAGE(PG8_SB(0, 1), cB + hstep, voffB); PG8_STAGE(PG8_SA(0, 1), cA + hstep, voffA);
        if (wr == 1) PG8_BAR;
        PG8_WAIT_V(4); PG8_BAR;
        PG8_STAGE(PG8_SB(1, 0), cB + kstep, voffB); PG8_STAGE(PG8_SA(1, 0), cA + kstep, voffA); PG8_STAGE(PG8_SB(1, 1), cB + hstep + kstep, voffB);
        PG8_WAIT_V(6); PG8_BAR;
    }
    for (;;) {
        const bool has_next = S.next(ui + 1, nxt);
        const char* nA = has_next ? nxt.a : cA; const char* nB = has_next ? nxt.b : cB;
        const int nt = cur.nt;
        for (int t = 0; t < nt; t += 2) {
            const bool last = (t == nt - 2);
            const char* a1 = cA + (size_t)(t + 1) * kstep;
            const char* a2 = last ? nA : cA + (size_t)(t + 2) * kstep; const char* b2 = last ? nB : cB + (size_t)(t + 2) * kstep;
            const char* a3 = a2 + kstep; const char* b3 = b2 + kstep;
            if constexpr (SP2) {
            PG8_LDB(B0, 0, 0); PG8_LDB(B1, 0, 1); PG8_SCHED; PG8_LDA(At, 0, 0); PG8_STAGE(PG8_SA(1, 1), a1 + hstep, voffA);
            PG8_WAIT_V(8); PG8_WAIT_L(0); PG8_BAR; PG8_MMA(0, 0, At, B0); PG8_MMA(0, 1, At, B1); PG8_BAR; PG8_SCHED;
            PG8_LDA(At, 0, 1); PG8_STAGE(PG8_SB(0, 0), b2, voffB); PG8_STAGE(PG8_SB(0, 1), b2 + hstep, voffB); PG8_STAGE(PG8_SA(0, 0), a2, voffA);
            PG8_WAIT_V(8); PG8_WAIT_L(0); PG8_BAR; PG8_MMA(1, 0, At, B0); PG8_MMA(1, 1, At, B1); PG8_BAR; PG8_SCHED;
            PG8_LDB(B0, 1, 0); PG8_LDB(B1, 1, 1); PG8_SCHED; PG8_LDA(At, 1, 0); PG8_STAGE(PG8_SA(0, 1), a2 + hstep, voffA);
            PG8_WAIT_V(8); PG8_WAIT_L(0); PG8_BAR; PG8_MMA(0, 0, At, B0); PG8_MMA(0, 1, At, B1); PG8_BAR; PG8_SCHED;
            PG8_LDA(At, 1, 1); PG8_STAGE(PG8_SB(1, 0), b3, voffB); PG8_STAGE(PG8_SB(1, 1), b3 + hstep, voffB); PG8_STAGE(PG8_SA(1, 0), a3, voffA);
            PG8_WAIT_V(8); PG8_WAIT_L(0); PG8_BAR; PG8_MMA(1, 0, At, B0); PG8_MMA(1, 1, At, B1); PG8_BAR; PG8_SCHED;
            } else {
            PG8_LDB(B0, 0, 0); PG8_SCHED; PG8_LDA(At, 0, 0); PG8_STAGE(PG8_SA(1, 1), a1 + hstep, voffA);
            PG8_WAIT_L(8); PG8_BAR; PG8_WAIT_L(0); PG8_MMA(0, 0, At, B0); PG8_BAR; PG8_SCHED;
            PG8_LDB(B1, 0, 1); PG8_STAGE(PG8_SB(0, 0), b2, voffB);
            PG8_BAR; PG8_WAIT_L(0); PG8_MMA(0, 1, At, B1); PG8_BAR;
            PG8_LDA(At, 0, 1); PG8_STAGE(PG8_SA(0, 0), a2, voffA);
            PG8_BAR; PG8_WAIT_L(0); PG8_MMA(1, 0, At, B0); PG8_BAR; PG8_SCHED;
            PG8_STAGE(PG8_SB(0, 1), b2 + hstep, voffB);
            PG8_WAIT_V(6); PG8_BAR; PG8_MMA(1, 1, At, B1); PG8_BAR;
            PG8_LDB(B0, 1, 0); PG8_SCHED; PG8_LDA(At, 1, 0); PG8_STAGE(PG8_SA(0, 1), a2 + hstep, voffA);
            PG8_WAIT_L(8); PG8_BAR; PG8_WAIT_L(0); PG8_MMA(0, 0, At, B0); PG8_BAR; PG8_SCHED;
            PG8_LDB(B1, 1, 1); PG8_STAGE(PG8_SB(1, 0), b3, voffB);
            PG8_BAR; PG8_WAIT_L(0); PG8_MMA(0, 1, At, B1); PG8_BAR;
            PG8_LDA(At, 1, 1); PG8_STAGE(PG8_SA(1, 0), a3, voffA);
            PG8_BAR; PG8_WAIT_L(0); PG8_MMA(1, 0, At, B0); PG8_BAR; PG8_SCHED;
            PG8_STAGE(PG8_SB(1, 1), b3 + hstep, voffB);
            PG8_WAIT_V(6); PG8_BAR; PG8_MMA(1, 1, At, B1); PG8_BAR;
            }
        }
        if constexpr (ALIGN_EPI) { if (wr == 0) PG8_BAR; }
        E(acc, cur, wr, wc, fr, fq);
        if (!has_next) break;
#pragma unroll
        for (int a = 0; a < 2; ++a)
#pragma unroll
            for (int b = 0; b < 2; ++b)
#pragma unroll
                for (int m = 0; m < 4; ++m)
#pragma unroll
                    for (int n = 0; n < 2; ++n) acc[a][b][m][n] = (f32x4){0.f, 0.f, 0.f, 0.f};
        cur = nxt; cA = nA; cB = nB; ++ui;
        if constexpr (ALIGN_EPI) { if (wr == 1) PG8_BAR; }
    }
    PG8_WAIT_V(0);
    if constexpr (!ALIGN_EPI) { if (wr == 0) PG8_BAR; }
    PG8_BAR;
#undef PG8_SA
#undef PG8_SB
#undef PG8_STAGE
#undef PG8_LDA
#undef PG8_LDB
#undef PG8_MMA
#undef PG8_WAIT_V
#undef PG8_WAIT_L
#undef PG8_BAR
#undef PG8_SCHED
}

struct EpiUp {
    static constexpr bool PERM = true;
    bf16_t* act;
    __device__ __forceinline__ void operator()(const f32x4 (&acc)[2][2][4][2], const Unit& u, int wr, int wc, int fr, int fq) const {
        asm volatile("" : "+v"(fr), "+v"(fq));
        const int row0 = u.pm * BM + wr * 64 + fr; const int col0 = u.pn * 128 + wc * 32 + 8 * fq;
#pragma unroll
        for (int ai = 0; ai < 2; ++ai)
#pragma unroll
            for (int m = 0; m < 4; ++m) {
                bf16_t* rowp = act + (size_t)(row0 + ai * HALF + m * 16) * FF + col0;
                const f32x4 g0 = acc[ai][0][m][0], g1 = acc[ai][0][m][1], u0 = acc[ai][1][m][0], u1 = acc[ai][1][m][1];
                u32x4 w;
                w.x = cvt_pk_bf16(silu_f(g0[0]) * u0[0], silu_f(g0[1]) * u0[1]); w.y = cvt_pk_bf16(silu_f(g0[2]) * u0[2], silu_f(g0[3]) * u0[3]);
                w.z = cvt_pk_bf16(silu_f(g1[0]) * u1[0], silu_f(g1[1]) * u1[1]); w.w = cvt_pk_bf16(silu_f(g1[2]) * u1[2], silu_f(g1[3]) * u1[3]);
                *(u32x4*)rowp = w;
            }
    }
};
struct EpiDown {
    static constexpr bool PERM = true;
    const float* xoldL; const float* xoldC; float* xnew; const float* gate; float gscale; float* part;
    __device__ __forceinline__ void operator()(const f32x4 (&acc)[2][2][4][2], const Unit& u, int wr, int wc, int fr, int fq) const {
        asm volatile("" : "+v"(fr), "+v"(fq));
        const int s = u.pm < 128 ? (u.pm >> 5) : 4;
        const int row0 = u.pm * BM + wr * 64 + fr; const int col0 = u.pn * BM + wc * 32 + 8 * fq;
        const float* xo = (u.pm < 128) ? xoldL + (size_t)row0 * DM : xoldC + (size_t)(row0 - RL) * DM;
        float* xn = xnew + (size_t)row0 * DM;
        const bool partial = (u.kind >= 1);
        float* pp = part + ((size_t)(u.kind - 1) * RC + (row0 - RL)) * DM;
        f32x4 gv[2][2];
#pragma unroll
        for (int bj = 0; bj < 2; ++bj)
#pragma unroll
            for (int n = 0; n < 2; ++n) gv[bj][n] = *(const f32x4*)(gate + (size_t)s * 9216 + col0 + bj * HALF + 4 * n) * gscale;
        if (partial) {
#pragma unroll
            for (int ai = 0; ai < 2; ++ai)
#pragma unroll
                for (int m = 0; m < 4; ++m) {
                    const size_t ro = (size_t)(ai * HALF + m * 16) * DM + col0;
#pragma unroll
                    for (int bj = 0; bj < 2; ++bj)
#pragma unroll
                        for (int n = 0; n < 2; ++n) *(f32x4*)(pp + ro + bj * HALF + 4 * n) = acc[ai][bj][m][n];
                }
        } else {
#pragma unroll
            for (int ai = 0; ai < 2; ++ai) {
                f32x4 xv[4][2][2];
#pragma unroll
                for (int m = 0; m < 4; ++m)
#pragma unroll
                    for (int bj = 0; bj < 2; ++bj)
#pragma unroll
                        for (int n = 0; n < 2; ++n) xv[m][bj][n] = *(const f32x4*)(xo + (size_t)(ai * HALF + m * 16) * DM + col0 + bj * HALF + 4 * n);
                __builtin_amdgcn_sched_barrier(0);
#pragma unroll
                for (int m = 0; m < 4; ++m)
#pragma unroll
                    for (int bj = 0; bj < 2; ++bj)
#pragma unroll
                        for (int n = 0; n < 2; ++n) *(f32x4*)(xn + (size_t)(ai * HALF + m * 16) * DM + col0 + bj * HALF + 4 * n) = xv[m][bj][n] + gv[bj][n] * acc[ai][bj][m][n];
                __builtin_amdgcn_sched_barrier(0);
            }
        }
    }
};
struct EpiMix {
    static constexpr bool PERM = true;
    unsigned char* mx;
    const float* gq; const float* gk;
    __device__ __forceinline__ void operator()(const f32x4 (&acc)[2][2][4][2], const Unit& u, int wr, int wc, int fr, int fq) const {
        asm volatile("" : "+v"(fr), "+v"(fq));
        if (u.kind == 1) {
            bf16_t* O = (bf16_t*)(mx + MX_VT);
            const int row0 = u.pm * BM + wr * 64 + fr, col0 = u.pn * BM + wc * 32 + 8 * fq;
#pragma unroll
            for (int ai = 0; ai < 2; ++ai)
#pragma unroll
                for (int m = 0; m < 4; ++m) { bf16_t* rowp = O + (size_t)(row0 + ai * HALF + m * 16) * R + col0;
#pragma unroll
                    for (int bj = 0; bj < 2; ++bj) { const f32x4 v0 = acc[ai][bj][m][0], v1 = acc[ai][bj][m][1]; u32x4 w;
                        w.x = cvt_pk_bf16(v0[0], v0[1]); w.y = cvt_pk_bf16(v0[2], v0[3]); w.z = cvt_pk_bf16(v1[0], v1[1]); w.w = cvt_pk_bf16(v1[2], v1[3]);
                        *(u32x4*)(rowp + bj * HALF) = w; } }
            return;
        }
        const int row0 = u.pm * BM + wr * 64 + fr;
        const bool latent = u.pm < 128;
        if (u.pn <= 1) {
            const int slot = u.pn * 4 + wc; const bool isq = slot < 6;
            const float* g = isq ? gq : gk;
            bf16_t* dst = isq ? (bf16_t*)(mx + MX_QA) + (size_t)slot * R * 64 : (bf16_t*)(mx + MX_KA) + (size_t)(slot - 6) * R * 64;
            float fr0[2], fr1[2];
#pragma unroll
            for (int n = 0; n < 2; ++n) { const float p = (float)(4 * fq + 2 * n);
                fr0[n] = fast_exp2(-p * (13.287712379549449f / 16.0f)) * 0.15915494309189535f; fr1[n] = fast_exp2(-(p + 1.0f) * (13.287712379549449f / 16.0f)) * 0.15915494309189535f; }
#pragma unroll
            for (int ai = 0; ai < 2; ++ai)
#pragma unroll
                for (int m = 0; m < 4; ++m) {
                    const int row = row0 + ai * HALF + m * 16;
                    int fqo = fq; asm volatile("" : "+v"(fqo));
                    f32x4 v[2][2]; float ss = 0.f;
#pragma unroll
                    for (int bj = 0; bj < 2; ++bj)
#pragma unroll
                        for (int n = 0; n < 2; ++n) { v[bj][n] = acc[ai][bj][m][n]; ss += (v[bj][n][0] * v[bj][n][0] + v[bj][n][1] * v[bj][n][1]) + (v[bj][n][2] * v[bj][n][2] + v[bj][n][3] * v[bj][n][3]); }
                    ss += swz_xor<16>(ss); ss = xadd32(ss);
                    const float rstd = __builtin_amdgcn_rsqf(ss * (1.0f / 64.0f) + EPS);
                    const int t = row & (SEQ - 1); const float pos[2] = {(float)(t >> 6), (float)(t & 63)};
#pragma unroll
                    for (int bj = 0; bj < 2; ++bj) {
                        u32x4 w;
#pragma unroll
                        for (int n = 0; n < 2; ++n) {
                            f32x4 x = v[bj][n] * rstd * *(const f32x4*)(g + 32 * bj + 8 * fqo + 4 * n);
                            if (latent) {
                                const float a0 = pos[bj] * fr0[n], a1 = pos[bj] * fr1[n];
                                const float c0 = __builtin_amdgcn_cosf(a0), s0 = __builtin_amdgcn_sinf(a0), c1 = __builtin_amdgcn_cosf(a1), s1 = __builtin_amdgcn_sinf(a1);
                                x = (f32x4){x[0] * c0 - x[1] * s0, x[1] * c0 + x[0] * s0, x[2] * c1 - x[3] * s1, x[3] * c1 + x[2] * s1};
                            }
                            if (n == 0) { w.x = cvt_pk_bf16(x[0], x[1]); w.y = cvt_pk_bf16(x[2], x[3]); } else { w.z = cvt_pk_bf16(x[0], x[1]); w.w = cvt_pk_bf16(x[2], x[3]); }
                        }
                        *(u32x4*)(dst + (size_t)row * 64 + 32 * bj + 8 * fq) = w;
                    }
                    __builtin_amdgcn_sched_barrier(0);
                }
        } else if (u.pn <= 3) {
            bf16_t* dst = (bf16_t*)(mx + (u.pn == 2 ? MX_U : MX_VG));
            const int col0 = wc * 32 + 8 * fq;
#pragma unroll
            for (int ai = 0; ai < 2; ++ai)
#pragma unroll
                for (int m = 0; m < 4; ++m) { bf16_t* rowp = dst + (size_t)(row0 + ai * HALF + m * 16) * 256 + col0;
#pragma unroll
                    for (int bj = 0; bj < 2; ++bj) { const f32x4 v0 = acc[ai][bj][m][0], v1 = acc[ai][bj][m][1]; u32x4 w;
                        w.x = cvt_pk_bf16(gelu_tanh_f(v0[0]), gelu_tanh_f(v0[1])); w.y = cvt_pk_bf16(gelu_tanh_f(v0[2]), gelu_tanh_f(v0[3]));
                        w.z = cvt_pk_bf16(gelu_tanh_f(v1[0]), gelu_tanh_f(v1[1])); w.w = cvt_pk_bf16(gelu_tanh_f(v1[2]), gelu_tanh_f(v1[3]));
                        *(u32x4*)(rowp + bj * HALF) = w; } }
        } else {
#pragma unroll
            for (int bj = 0; bj < 2; ++bj) {
                const int j = (u.pn - 4) * 256 + 128 * bj + 32 * wc + 8 * fq;
                const int which = j >= 384 ? 1 : 0; const int rem = j - which * 384; const int ch = rem / 48; const int sidx = rem - ch * 48;
                const int blk = sidx >= 24 ? 1 : 0; const int ii = sidx - blk * 24;
                bf16_t* dst = (bf16_t*)(mx + (which ? MX_KC : MX_QC)) + (size_t)ch * R * 48 + sidx;
                const float qs = which ? 1.0f : 0.14433756729740643f * LOG2E;
                float fq4[4];
#pragma unroll
                for (int e = 0; e < 4; ++e) fq4[e] = fast_exp2(-(float)(ii / 2 + e) * (13.287712379549449f / 12.0f)) * 0.15915494309189535f;
#pragma unroll
                for (int ai = 0; ai < 2; ++ai)
#pragma unroll
                    for (int m = 0; m < 4; ++m) {
                        const int row = row0 + ai * HALF + m * 16;
                        f32x4 x0 = acc[ai][bj][m][0] * qs, x1 = acc[ai][bj][m][1] * qs;
                        if (latent) {
                            const int t = row & (SEQ - 1); const float pos = blk ? (float)(t & 63) : (float)(t >> 6);
                            const float a0 = pos * fq4[0], a1 = pos * fq4[1], a2 = pos * fq4[2], a3 = pos * fq4[3];
                            const float c0 = __builtin_amdgcn_cosf(a0), s0 = __builtin_amdgcn_sinf(a0), c1 = __builtin_amdgcn_cosf(a1), s1 = __builtin_amdgcn_sinf(a1);
                            const float c2 = __builtin_amdgcn_cosf(a2), s2 = __builtin_amdgcn_sinf(a2), c3 = __builtin_amdgcn_cosf(a3), s3 = __builtin_amdgcn_sinf(a3);
                            x0 = (f32x4){x0[0] * c0 - x0[1] * s0, x0[1] * c0 + x0[0] * s0, x0[2] * c1 - x0[3] * s1, x0[3] * c1 + x0[2] * s1};
                            x1 = (f32x4){x1[0] * c2 - x1[1] * s2, x1[1] * c2 + x1[0] * s2, x1[2] * c3 - x1[3] * s3, x1[3] * c3 + x1[2] * s3};
                        }
                        u32x4 w; w.x = cvt_pk_bf16(x0[0], x0[1]); w.y = cvt_pk_bf16(x0[2], x0[3]); w.z = cvt_pk_bf16(x1[0], x1[1]); w.w = cvt_pk_bf16(x1[2], x1[3]);
                        *(u32x4*)(dst + (size_t)row * 48) = w;
                        __builtin_amdgcn_sched_barrier(0);
                    }
            }
        }
    }
};
}

struct Args { const float* in[23]; float* out; unsigned char* ws; };
enum { I_X = 0, I_C, I_CTX, I_CCTX, I_WMOD, I_BMOD, I_GFFN1, I_W1IN, I_W1OUT, I_GMIX, I_WMIXIN, I_WMIXOUT, I_GQ, I_GK, I_GV, I_WS, I_BS, I_LAM, I_GSUB, I_GFFN2, I_W2IN, I_W2OUT, I_GFINAL };

__device__ __forceinline__ int ffn_in_src(int n) { const int pn = n >> 8, j = n & 255, bj = j >> 7, jj = j & 127; return bj * FF + pn * 128 + jj; }
__device__ __forceinline__ int mix_in_src(int n) {
    if (n < 512) { const int tile = n >> 8, j = n & 255, bj = j >> 7, wc = (j & 127) >> 5, i = j & 31; const int slot = tile * 4 + wc; return slot * 64 + bj * 32 + (i >> 1) + 16 * (i & 1); }
    if (n < 768) return 640 + (n - 512);
    if (n < 1024) return 896 + (n - 768);
    if (n < 1792) { const int j = n - 1024, which = j >= 384 ? 1 : 0, rem = j - which * 384, ch = rem / 48, sidx = rem - ch * 48, blk = sidx >= 24 ? 1 : 0, ii = sidx - blk * 24;
        return (which ? 1536 : 1152) + ch * 48 + blk * 24 + (ii >> 1) + 12 * (ii & 1); }
    const int v = n - 1792; return v < 128 ? 512 + v : 1920 + (v - 128);
}
template <int MAP>
__device__ __forceinline__ void transpose_item(const float* W, int K, int N, bf16_t* WT, LAS float* scr, int item, int nblk, int lane) {
    const int kb = item / nblk, nb = item % nblk, k0 = 64 * kb, n0 = 32 * nb;
    const bool contig = (MAP == 0) || (MAP == 1) || (n0 >= 512 && n0 < 1024) || (n0 >= 1792);
    if (contig) {
        const int src0 = MAP == 0 ? n0 : (MAP == 1 ? ffn_in_src(n0) : mix_in_src(n0));
        const int c4 = lane & 7; f32x4 v[8];
#pragma unroll
        for (int i = 0; i < 8; ++i) v[i] = *(const f32x4*)(W + (size_t)(k0 + (lane >> 3) + 8 * i) * N + src0 + 4 * c4);
#pragma unroll
        for (int i = 0; i < 8; ++i) { LAS float* d = scr + ((lane >> 3) + 8 * i) * 33 + 4 * c4; d[0] = v[i][0]; d[1] = v[i][1]; d[2] = v[i][2]; d[3] = v[i][3]; }
    } else {
        const int nn = n0 + (lane & 31); const int src = MAP == 0 ? nn : (MAP == 1 ? ffn_in_src(nn) : mix_in_src(nn));
#pragma unroll 8
        for (int i = 0; i < 32; ++i) { const int kk = 2 * i + (lane >> 5); scr[kk * 33 + (lane & 31)] = W[(size_t)(k0 + kk) * N + src]; }
    }
    asm volatile("s_waitcnt lgkmcnt(0)" ::: "memory");
    const int c = lane & 7;
#pragma unroll
    for (int j = 0; j < 4; ++j) { const int n = (lane >> 3) + 8 * j; const LAS float* s = scr + (8 * c) * 33 + n;
        u32x4 o; o.x = cvt_pk_bf16(s[0 * 33], s[1 * 33]); o.y = cvt_pk_bf16(s[2 * 33], s[3 * 33]); o.z = cvt_pk_bf16(s[4 * 33], s[5 * 33]); o.w = cvt_pk_bf16(s[6 * 33], s[7 * 33]);
        *(u32x4*)(WT + (size_t)(n0 + n) * K + k0 + 8 * c) = o; }
    asm volatile("s_waitcnt lgkmcnt(0)" ::: "memory");
}

__device__ __forceinline__ void phase0(const Args& a, LAS unsigned char* lds, int tid, int lane, int wave) {
    const int G = gridDim.x;
    {
        LAS float* sc = (LAS float*)lds;
        LAS float* red = (LAS float*)(lds + 5 * 1024 * 4);
        for (int i = tid; i < 5 * 1024; i += NTHREADS) { const int s = i >> 10, k = i & 1023; const float v = s < 4 ? a.in[I_C][s * 1024 + k] : a.in[I_CCTX][k]; sc[i] = silu_f(v); }
        __syncthreads();
        float* modv = (float*)(a.ws + WS_MODV);
        for (int u = blockIdx.x; u < DEPTH * 72; u += G) {
            const int l = u / 72, n0 = (u % 72) * 128; const int kq = tid >> 7, col = tid & 127;
            const float* W = a.in[I_WMOD] + (size_t)l * 1024 * 9216 + n0 + col;
            float acc[5] = {0.f, 0.f, 0.f, 0.f, 0.f};
#pragma unroll 8
            for (int k = kq; k < 1024; k += 4) { const float w = W[(size_t)k * 9216];
#pragma unroll
                for (int s = 0; s < 5; ++s) acc[s] += sc[s * 1024 + k] * w; }
#pragma unroll
            for (int s = 0; s < 5; ++s) red[(kq * 5 + s) * 128 + col] = acc[s];
            __syncthreads();
            for (int i = tid; i < 5 * 128; i += NTHREADS) { const int s = i >> 7, c = i & 127;
                const float v = red[(0 * 5 + s) * 128 + c] + red[(1 * 5 + s) * 128 + c] + red[(2 * 5 + s) * 128 + c] + red[(3 * 5 + s) * 128 + c];
                modv[((size_t)l * 5 + s) * 9216 + n0 + c] = v + a.in[I_BMOD][(size_t)l * 9216 + n0 + c]; }
            __syncthreads();
        }
    }
    {
        float* xc = (float*)(a.ws + WS_XRES) + (size_t)RL * DM;
        for (int i = blockIdx.x * NTHREADS + tid; i < RC * DM / 4; i += G * NTHREADS) ((f32x4*)xc)[i] = ((const f32x4*)a.in[I_CTX])[i];
    }
    if (blockIdx.x == 0) {
        float* gt = (float*)(a.ws + WS_GTAB);
        for (int i = tid; i < DEPTH * 128; i += NTHREADS) { const int l = i >> 7, isk = (i >> 6) & 1, sidx = i & 63, bj = sidx >> 5, ii = sidx & 31;
            const int tc = 32 * bj + (ii >> 1) + 16 * (ii & 1);
            gt[i] = isk ? a.in[I_GK][l * 64 + tc] : a.in[I_GQ][l * 64 + tc] * (0.125f * LOG2E); }
    }
    __syncthreads();
    {
        LAS float* scr = (LAS float*)(lds + wave * 16384);
        const int gw = blockIdx.x * NWAVES + wave, NGW = G * NWAVES;
        constexpr int I1 = 16 * 176, I2 = 44 * 32, I3 = 16 * 72, I4 = 16 * 32;
        constexpr int PER_LAYER = I1 + I2 + I3 + I4 + I1 + I2;
        for (int it = gw; it < DEPTH * PER_LAYER; it += NGW) {
            const int l = it / PER_LAYER; int r = it % PER_LAYER;
            unsigned char* wl = a.ws + WS_W + (size_t)l * LAYER_W_BYTES;
            if (r < I1) { transpose_item<1>(a.in[I_W1IN] + (size_t)l * 1024 * 5632, 1024, 5632, (bf16_t*)(wl + W_1IN), scr, r, 176, lane); continue; } r -= I1;
            if (r < I2) { transpose_item<0>(a.in[I_W1OUT] + (size_t)l * 2816 * 1024, 2816, 1024, (bf16_t*)(wl + W_1OUT), scr, r, 32, lane); continue; } r -= I2;
            if (r < I3) { transpose_item<2>(a.in[I_WMIXIN] + (size_t)l * 1024 * 2304, 1024, 2304, (bf16_t*)(wl + W_MIX), scr, r, 72, lane); continue; } r -= I3;
            if (r < I4) { transpose_item<0>(a.in[I_WMIXOUT] + (size_t)l * 1024 * 1024, 1024, 1024, (bf16_t*)(wl + W_OUT), scr, r, 32, lane); continue; } r -= I4;
            if (r < I1) { transpose_item<1>(a.in[I_W2IN] + (size_t)l * 1024 * 5632, 1024, 5632, (bf16_t*)(wl + W_2IN), scr, r, 176, lane); continue; } r -= I1;
            transpose_item<0>(a.in[I_W2OUT] + (size_t)l * 2816 * 1024, 2816, 1024, (bf16_t*)(wl + W_2OUT), scr, r, 32, lane);
        }
    }
}

__device__ __forceinline__ void norm_row(const f32x4 (&v)[4], const f32x4 (&gn)[4], const float* sh, bf16_t* hrow, int lane) {
    const float* scl = sh + 1024;
    f32x4 sv[4], cv[4];
#pragma unroll
    for (int j = 0; j < 4; ++j) { sv[j] = *(const f32x4*)(sh + 4 * lane + 256 * j); cv[j] = *(const f32x4*)(scl + 4 * lane + 256 * j); }
    float ss = 0.f;
#pragma unroll
    for (int j = 0; j < 4; ++j) ss += (v[j][0] * v[j][0] + v[j][1] * v[j][1]) + (v[j][2] * v[j][2] + v[j][3] * v[j][3]);
    const float rstd = __builtin_amdgcn_rsqf(wave_sum(ss) * (1.0f / DM) + EPS);
#pragma unroll
    for (int j = 0; j < 4; ++j) {
        const f32x4 y = v[j] * rstd * gn[j] * (cv[j] + 1.0f) + sv[j];
        u32x2 w; w.x = cvt_pk_bf16(y[0], y[1]); w.y = cvt_pk_bf16(y[2], y[3]);
        *(u32x2*)(hrow + 4 * lane + 256 * j) = w;
    }
}
__device__ __forceinline__ void norm_phase(const float* xL, const float* xC, const float* gain, const float* modl  , int ishift, bf16_t* H, int nrows,
                                           const float* part, int nsplit, const float* pgate  , float pscale, float* xCw) {
    const int tid_ = opaque_tid(); const int lane = tid_ & 63, wave = __builtin_amdgcn_readfirstlane(tid_ >> 6);
    const int gw = blockIdx.x * NWAVES + wave, NGW = gridDim.x * NWAVES;
    f32x4 gn[4];
#pragma unroll
    for (int j = 0; j < 4; ++j) gn[j] = *(const f32x4*)(gain + 4 * lane + 256 * j);
    const int nplain = (nsplit > 0 && nrows > RL) ? RL : nrows;
    {
        int row = gw; f32x4 v[4], vn[4];
        if (row < nplain) { const float* xr = row < RL ? xL + (size_t)row * DM : xC + (size_t)(row - RL) * DM;
#pragma unroll
            for (int j = 0; j < 4; ++j) v[j] = *(const f32x4*)(xr + 4 * lane + 256 * j); }
        for (; row < nplain; row += NGW) {
            const int rn = row + NGW;
            if (rn < nplain) { const float* xr = rn < RL ? xL + (size_t)rn * DM : xC + (size_t)(rn - RL) * DM;
#pragma unroll
                for (int j = 0; j < 4; ++j) vn[j] = *(const f32x4*)(xr + 4 * lane + 256 * j); }
            const int s = row < RL ? (row >> 13) : 4;
            norm_row(v, gn, modl + (size_t)s * 9216 + ishift * 1024, H + (size_t)row * DM, lane);
#pragma unroll
            for (int j = 0; j < 4; ++j) v[j] = vn[j];
        }
    }
    if (nsplit > 0) for (int row = RL + gw; row < nrows; row += NGW) {
        f32x4 v[4];
        const float* xr = xC + (size_t)(row - RL) * DM;
#pragma unroll
        for (int j = 0; j < 4; ++j) v[j] = *(const f32x4*)(xr + 4 * lane + 256 * j);
#pragma unroll
        for (int j = 0; j < 4; ++j) {
            f32x4 pv[11];
#pragma unroll
            for (int ks = 0; ks < 11; ++ks) if (ks < nsplit) pv[ks] = *(const f32x4*)(part + ((size_t)ks * RC + (row - RL)) * DM + 4 * lane + 256 * j);
            f32x4 sum = {0.f, 0.f, 0.f, 0.f};
#pragma unroll
            for (int ks = 0; ks < 11; ++ks) if (ks < nsplit) sum += pv[ks];
            v[j] += sum * (*(const f32x4*)(pgate + 4 * lane + 256 * j) * pscale);
            *(f32x4*)(xCw + (size_t)(row - RL) * DM + 4 * lane + 256 * j) = v[j];
        }
        norm_row(v, gn, modl + (size_t)4 * 9216 + ishift * 1024, H + (size_t)row * DM, lane);
    }
}
__device__ __forceinline__ void final_phase(const float* x, const float* gain, float* out) {
    const int tid_ = opaque_tid(); const int lane = tid_ & 63, wave = __builtin_amdgcn_readfirstlane(tid_ >> 6);
    const int gw = blockIdx.x * NWAVES + wave, NGW = gridDim.x * NWAVES;
    f32x4 gn[4];
#pragma unroll
    for (int j = 0; j < 4; ++j) gn[j] = *(const f32x4*)(gain + 4 * lane + 256 * j);
    int row = gw; f32x4 v[4], vn[4];
    if (row < RL) {
#pragma unroll
        for (int j = 0; j < 4; ++j) v[j] = *(const f32x4*)(x + (size_t)row * DM + 4 * lane + 256 * j); }
    for (; row < RL; row += NGW) {
        const int rn = row + NGW;
        if (rn < RL) {
#pragma unroll
            for (int j = 0; j < 4; ++j) vn[j] = *(const f32x4*)(x + (size_t)rn * DM + 4 * lane + 256 * j); }
        float ss = 0.f;
#pragma unroll
        for (int j = 0; j < 4; ++j) ss += (v[j][0] * v[j][0] + v[j][1] * v[j][1]) + (v[j][2] * v[j][2] + v[j][3] * v[j][3]);
        const float rstd = __builtin_amdgcn_rsqf(wave_sum(ss) * (1.0f / DM) + EPS);
#pragma unroll
        for (int j = 0; j < 4; ++j) *(f32x4*)(out + (size_t)row * DM + 4 * lane + 256 * j) = v[j] * rstd * gn[j];
#pragma unroll
        for (int j = 0; j < 4; ++j) v[j] = vn[j];
    }
}

__device__ __forceinline__ int pi16(int t) { return (t & ~12) | ((t & 8) >> 1) | ((t & 4) << 1); }
template <int NS, int DQK, int DV, bool KSH  >
__device__ __forceinline__ void attn_unit(LAS unsigned char* lds, const bf16_t* Qh0, const bf16_t* Kh0, const int sstride  , const bf16_t* Vt  ,
                                          int qrow0, int bidx, int tlo, int thi, bf16_t* Y  , float lam, const float* gsub, float outscale) {
    constexpr int CK = DQK / 8, KS = DQK / 16, NDB = DV / 32;
    constexpr int NKS = KSH ? 1 : NS;
    constexpr int KBYTES = NKS * CK * 1024, VBYTES = 8 * DV * 16, BUFB = KBYTES + VBYTES;
    constexpr int NKW = NKS * CK, NVP = DV * 8;
    constexpr int NKL = (NKW + NWAVES - 1) / NWAVES, NVL = (NVP + NTHREADS - 1) / NTHREADS;
    const int tid = opaque_tid(), lane = tid & 63, r32 = lane & 31, hi = lane >> 5; const int wid = __builtin_amdgcn_readfirstlane(tid >> 6);
    LAS float* wsf = (LAS float*)(lds + 3 * BUFB) + wid * 64;
    int kg[NKL]; int vg[NVL];
#pragma unroll
    for (int i = 0; i < NKL; ++i) { const int cck = wid + i * NWAVES; const int c2 = cck < NKW ? cck : 0; const int c = c2 / CK, ck = c2 % CK; kg[i] = c * sstride + pi16(lane) * DQK + ck * 8; }
#pragma unroll
    for (int i = 0; i < NVL; ++i) { const int idx = tid + i * NTHREADS; const int id2 = idx < NVP ? idx : 0; const int c8 = id2 / DV, d = id2 % DV; vg[i] = d * R + c8 * 8; }
    auto tokbase = [&](int t) -> int { return t < 128 ? bidx * SEQ + 64 * t : RL + bidx * CTXL + 64 * (t - 128); };
#define ATT_DMA(T, BOFF) do { const int tb_ = tokbase(T); \
        _Pragma("unroll") for (int i_ = 0; i_ < NKL; ++i_) if (wid + i_ * NWAVES < NKW) \
            __builtin_amdgcn_global_load_lds((const unsigned*)(Kh0 + (kg[i_] + tb_ * DQK)), (LAS unsigned*)(lds + (BOFF) + (wid + i_ * NWAVES) * 1024), 16, 0, 0); \
        _Pragma("unroll") for (int i_ = 0; i_ < NVL; ++i_) if (wid * 64 + i_ * NTHREADS < NVP) \
            __builtin_amdgcn_global_load_lds((const unsigned*)(Vt + (vg[i_] + tb_)), (LAS unsigned*)(lds + (BOFF) + KBYTES + (wid * 64 + i_ * NTHREADS) * 16), 16, 0, 0); } while (0)
#define ATT_SYNC() do { asm volatile("s_waitcnt vmcnt(0)" ::: "memory"); __syncthreads(); } while (0)
    constexpr bool QLDS = (NS > 1);
    LAS unsigned char* qlds = lds + 3 * BUFB + 2048 + wid * 1024 + lane * 16;
    bf16x8 qr[QLDS ? 1 : NS][QLDS ? 1 : KS];
#pragma unroll
    for (int c = 0; c < NS; ++c)
#pragma unroll
        for (int d0 = 0; d0 < KS; ++d0) {
            const bf16x8 qv = *(const bf16x8*)(Qh0 + (size_t)c * sstride + (size_t)(qrow0 + wid * 32 + r32) * DQK + d0 * 16 + hi * 8);
            if constexpr (QLDS) *(LAS bf16x8*)(qlds + (c * KS + d0) * 8192) = qv; else qr[c][d0] = qv;
        }
    f32x16 o[NS][NDB];
#pragma unroll
    for (int c = 0; c < NS; ++c)
#pragma unroll
        for (int d = 0; d < NDB; ++d)
#pragma unroll
            for (int r = 0; r < 16; ++r) o[c][d][r] = 0.f;
    float mrun[NS], lrun[NS];
#pragma unroll
    for (int c = 0; c < NS; ++c) { mrun[c] = 0.f; lrun[c] = 0.f; }
    f32x16 pA0, pA1, pB0, pB1;
    bf16x8 pa0, pa1, pa2, pa3;
#define ATT_QK(P0, P1, C, BOFF) do { \
        _Pragma("unroll") for (int r_ = 0; r_ < 16; ++r_) { P0[r_] = -mrun[C]; P1[r_] = -mrun[C]; } \
        const LAS unsigned char* kb_ = lds + (BOFF) + (KSH ? 0 : (C)) * CK * 1024 + hi * 1024 + r32 * 16; \
        int zo_ = 0; asm volatile("" : "+v"(zo_));     \
        _Pragma("unroll") for (int d0_ = 0; d0_ < KS; ++d0_) { \
            const bf16x8 ka_ = *(const LAS bf16x8*)(kb_ + d0_ * 2048), kc_ = *(const LAS bf16x8*)(kb_ + d0_ * 2048 + 512); \
            bf16x8 qf_; if constexpr (QLDS) qf_ = *(const LAS bf16x8*)(qlds + zo_ + ((C) * KS + d0_) * 8192); else qf_ = qr[QLDS ? 0 : (C)][QLDS ? 0 : d0_]; \
            P0 = __builtin_amdgcn_mfma_f32_32x32x16_bf16(ka_, qf_, P0, 0, 0, 0); \
            P1 = __builtin_amdgcn_mfma_f32_32x32x16_bf16(kc_, qf_, P1, 0, 0, 0); } } while (0)
#define ATT_MAX(P0, P1, C, FIRST) do { \
        float rm_ = max3f(P0[0], P1[0], P0[1]), rn_ = max3f(P1[1], P0[2], P1[2]); \
        _Pragma("unroll") for (int r_ = 3; r_ < 15; r_ += 2) { rm_ = max3f(rm_, P0[r_], P1[r_]); rn_ = max3f(rn_, P0[r_ + 1], P1[r_ + 1]); } \
        rm_ = max3f(rm_, P0[15], P1[15]); rm_ = max3f(rm_, rn_, rn_); \
        rm_ = xmax32(rm_); \
        const bool first_ = (FIRST); \
        if (first_ || __any(rm_ > 8.0f)) { \
            const float dl_ = first_ ? rm_ : fmaxf(rm_, 0.f); \
            mrun[C] += dl_; \
            _Pragma("unroll") for (int r_ = 0; r_ < 16; ++r_) { P0[r_] -= dl_; P1[r_] -= dl_; } \
            if (!first_) { \
                const float f_ = fast_exp2(-dl_); lrun[C] *= f_; \
                if (hi == 0) wsf[r32] = f_; \
                asm volatile("s_waitcnt lgkmcnt(0)" ::: "memory"); \
                _Pragma("unroll") for (int r_ = 0; r_ < 16; ++r_) { const float fr_ = wsf[crow(r_, hi)]; \
                    _Pragma("unroll") for (int d_ = 0; d_ < NDB; ++d_) o[C][d_][r_] *= fr_; } \
                asm volatile("s_waitcnt lgkmcnt(0)" ::: "memory"); \
            } } } while (0)
#define ATT_EXP(P0, P1, C) do { \
        float ls_ = 0.f; \
        _Pragma("unroll") for (int r_ = 0; r_ < 16; ++r_) { P0[r_] = fast_exp2(P0[r_]); P1[r_] = fast_exp2(P1[r_]); ls_ += P0[r_] + P1[r_]; } \
        lrun[C] += ls_; \
        u32x4 w0_, w1_, w2_, w3_; \
        w0_.x = cvt_pk_bf16(P0[0], P0[1]); w0_.y = cvt_pk_bf16(P0[2], P0[3]); w0_.z = cvt_pk_bf16(P0[4], P0[5]); w0_.w = cvt_pk_bf16(P0[6], P0[7]); \
        w1_.x = cvt_pk_bf16(P0[8], P0[9]); w1_.y = cvt_pk_bf16(P0[10], P0[11]); w1_.z = cvt_pk_bf16(P0[12], P0[13]); w1_.w = cvt_pk_bf16(P0[14], P0[15]); \
        w2_.x = cvt_pk_bf16(P1[0], P1[1]); w2_.y = cvt_pk_bf16(P1[2], P1[3]); w2_.z = cvt_pk_bf16(P1[4], P1[5]); w2_.w = cvt_pk_bf16(P1[6], P1[7]); \
        w3_.x = cvt_pk_bf16(P1[8], P1[9]); w3_.y = cvt_pk_bf16(P1[10], P1[11]); w3_.z = cvt_pk_bf16(P1[12], P1[13]); w3_.w = cvt_pk_bf16(P1[14], P1[15]); \
        pa0 = __builtin_bit_cast(bf16x8, w0_); pa1 = __builtin_bit_cast(bf16x8, w1_); pa2 = __builtin_bit_cast(bf16x8, w2_); pa3 = __builtin_bit_cast(bf16x8, w3_); } while (0)
#define ATT_QKEXP(PN0, PN1, CN, BOFF, PC0, PC1, CC) do { \
        __builtin_amdgcn_iglp_opt(1); \
        _Pragma("unroll") for (int r_ = 0; r_ < 16; ++r_) { PN0[r_] = -mrun[CN]; PN1[r_] = -mrun[CN]; } \
        const LAS unsigned char* kb_ = lds + (BOFF) + (KSH ? 0 : (CN)) * CK * 1024 + hi * 1024 + r32 * 16; \
        float ls_ = 0.f; unsigned w_[16]; \
        bf16x8 ka_[2], kc_[2], qf_[2];        \
        { int zo_ = 0; asm volatile("" : "+v"(zo_)); \
          ka_[0] = *(const LAS bf16x8*)(kb_ + zo_); kc_[0] = *(const LAS bf16x8*)(kb_ + zo_ + 512); \
          if constexpr (QLDS) qf_[0] = *(const LAS bf16x8*)(qlds + zo_ + ((CN) * KS) * 8192); else qf_[0] = qr[QLDS ? 0 : (CN)][0]; } \
        _Pragma("unroll") for (int d0_ = 0; d0_ < KS; ++d0_) { \
            if (d0_ + 1 < KS) { int zo_ = 0; asm volatile("" : "+v"(zo_)); \
                ka_[(d0_ + 1) & 1] = *(const LAS bf16x8*)(kb_ + zo_ + (d0_ + 1) * 2048); kc_[(d0_ + 1) & 1] = *(const LAS bf16x8*)(kb_ + zo_ + (d0_ + 1) * 2048 + 512); \
                if constexpr (QLDS) qf_[(d0_ + 1) & 1] = *(const LAS bf16x8*)(qlds + zo_ + ((CN) * KS + d0_ + 1) * 8192); else qf_[(d0_ + 1) & 1] = qr[QLDS ? 0 : (CN)][QLDS ? 0 : (d0_ + 1 < KS ? d0_ + 1 : 0)]; } \
            PN0 = __builtin_amdgcn_mfma_f32_32x32x16_bf16(ka_[d0_ & 1], qf_[d0_ & 1], PN0, 0, 0, 0); \
            PN1 = __builtin_amdgcn_mfma_f32_32x32x16_bf16(kc_[d0_ & 1], qf_[d0_ & 1], PN1, 0, 0, 0); \
            _Pragma("unroll") for (int r_ = ((16 * d0_ / KS) & ~1); r_ < (d0_ == KS - 1 ? 16 : ((16 * (d0_ + 1) / KS) & ~1)); r_ += 2) { \
                PC0[r_] = fast_exp2(PC0[r_]); PC0[r_ + 1] = fast_exp2(PC0[r_ + 1]); PC1[r_] = fast_exp2(PC1[r_]); PC1[r_ + 1] = fast_exp2(PC1[r_ + 1]); \
                ls_ += (PC0[r_] + PC0[r_ + 1]) + (PC1[r_] + PC1[r_ + 1]); \
                w_[r_ >> 1] = cvt_pk_bf16(PC0[r_], PC0[r_ + 1]); w_[8 + (r_ >> 1)] = cvt_pk_bf16(PC1[r_], PC1[r_ + 1]); } } \
        lrun[CC] += ls_; \
        pa0 = __builtin_bit_cast(bf16x8, (u32x4){w_[0], w_[1], w_[2], w_[3]}); pa1 = __builtin_bit_cast(bf16x8, (u32x4){w_[4], w_[5], w_[6], w_[7]}); \
        pa2 = __builtin_bit_cast(bf16x8, (u32x4){w_[8], w_[9], w_[10], w_[11]}); pa3 = __builtin_bit_cast(bf16x8, (u32x4){w_[12], w_[13], w_[14], w_[15]}); } while (0)
#define ATT_PV(C, BOFF) do { \
        const LAS unsigned char* vb_ = lds + (BOFF) + KBYTES + hi * DV * 16 + r32 * 16; \
        const bf16x8 pav_[4] = {pa0, pa1, pa2, pa3}; \
        bf16x8 vf_[2]; vf_[0] = *(const LAS bf16x8*)(vb_); \
        _Pragma("unroll") for (int i_ = 0; i_ < NDB * 4; ++i_) { \
            if (i_ + 1 < NDB * 4) vf_[(i_ + 1) & 1] = *(const LAS bf16x8*)(vb_ + (2 * ((i_ + 1) & 3)) * DV * 16 + ((i_ + 1) >> 2) * 512); \
            o[C][i_ >> 2] = __builtin_amdgcn_mfma_f32_32x32x16_bf16(pav_[i_ & 3], vf_[i_ & 1], o[C][i_ >> 2], 0, 0, 0); } } while (0)
    ATT_DMA(tlo, 0); ATT_DMA(tlo + 1, BUFB);
    ATT_SYNC();
    int bc = 0, bn = BUFB, bnn = 2 * BUFB;
    ATT_QK(pA0, pA1, 0, bc);
    if constexpr (NS == 1) {
        for (int t = tlo; t < thi; t += 2) {
            if (t + 2 < thi) ATT_DMA(t + 2, bnn);
            ATT_MAX(pA0, pA1, 0, t == tlo);
            ATT_QKEXP(pB0, pB1, 0, bn, pA0, pA1, 0);
            ATT_PV(0, bc);
            ATT_SYNC();
            if (t + 3 < thi) ATT_DMA(t + 3, bc);
            ATT_MAX(pB0, pB1, 0, false);
            ATT_QKEXP(pA0, pA1, 0, bnn, pB0, pB1, 0);
            ATT_PV(0, bn);
            ATT_SYNC();
            const int tmp = bc; bc = bnn; bnn = bn; bn = tmp;
        }
    } else if constexpr (NS == 3) {
        for (int t = tlo; t < thi; t += 2) {
            const bool first = (t == tlo);
            if (t + 2 < thi) ATT_DMA(t + 2, bnn);
            ATT_MAX(pA0, pA1, 0, first); ATT_QKEXP(pB0, pB1, 1, bc, pA0, pA1, 0); ATT_PV(0, bc);
            ATT_MAX(pB0, pB1, 1, first); ATT_QKEXP(pA0, pA1, NS - 1, bc, pB0, pB1, 1); ATT_PV(1, bc);
            ATT_MAX(pA0, pA1, NS - 1, first); ATT_QKEXP(pB0, pB1, 0, bn, pA0, pA1, NS - 1); ATT_PV(NS - 1, bc);
            ATT_SYNC();
            if (t + 3 < thi) ATT_DMA(t + 3, bc);
            ATT_MAX(pB0, pB1, 0, false); ATT_QKEXP(pA0, pA1, 1, bn, pB0, pB1, 0); ATT_PV(0, bn);
            ATT_MAX(pA0, pA1, 1, false); ATT_QKEXP(pB0, pB1, NS - 1, bn, pA0, pA1, 1); ATT_PV(1, bn);
            ATT_MAX(pB0, pB1, NS - 1, false); ATT_QKEXP(pA0, pA1, 0, bnn, pB0, pB1, NS - 1); ATT_PV(NS - 1, bn);
            ATT_SYNC();
            const int tmp = bc; bc = bnn; bnn = bn; bn = tmp;
        }
    } else {
        for (int t = tlo; t < thi; ++t) {
            if (t + 2 < thi) ATT_DMA(t + 2, bnn);
            ATT_MAX(pA0, pA1, 0, t == tlo);
            ATT_QKEXP(pB0, pB1, NS - 1, bc, pA0, pA1, 0);
            ATT_PV(0, bc);
            ATT_MAX(pB0, pB1, NS - 1, t == tlo);
            ATT_QKEXP(pA0, pA1, 0, bn, pB0, pB1, NS - 1);
            ATT_PV(NS - 1, bc);
            ATT_SYNC();
            const int tmp = bc; bc = bn; bn = bnn; bnn = tmp;
        }
    }
#undef ATT_DMA
#undef ATT_SYNC
#undef ATT_QK
#undef ATT_MAX
#undef ATT_EXP
#undef ATT_PV
#undef ATT_QKEXP
    float rl[NS][16];
#pragma unroll
    for (int c = 0; c < NS; ++c) {
        const float lt = xadd32(lrun[c]);
        if (hi == 0) wsf[r32] = fast_rcp(lt);
        asm volatile("s_waitcnt lgkmcnt(0)" ::: "memory");
#pragma unroll
        for (int r = 0; r < 16; ++r) rl[c][r] = wsf[crow(r, hi)];
        asm volatile("s_waitcnt lgkmcnt(0)" ::: "memory");
    }
    constexpr int NOUT = KSH ? NS * DV : DV;
    LAS bf16_t* stg = (LAS bf16_t*)(lds + (QLDS ? 3 * BUFB + 2048 : 0) + wid * (32 * NOUT * 2));
    if constexpr (KSH) {
#pragma unroll
        for (int c = 0; c < NS; ++c)
#pragma unroll
        for (int d = 0; d < NDB; ++d)
#pragma unroll
            for (int r = 0; r < 16; ++r) {
                const float v = o[c][d][r] * rl[c][r];
                stg[crow(r, hi) * NOUT + c * DV + d * 32 + r32] = (bf16_t)(cvt_pk_bf16(v, 0.f) & 0xffffu);
            }
    } else {
        float ss[16];
#pragma unroll
        for (int r = 0; r < 16; ++r) ss[r] = 0.f;
#pragma unroll
        for (int d = 0; d < NDB; ++d)
#pragma unroll
            for (int r = 0; r < 16; ++r) { const float v = o[0][d][r] * rl[0][r] - lam * (o[1][d][r] * rl[1][r]); o[0][d][r] = v; ss[r] += v * v; }
#pragma unroll
        for (int r = 0; r < 16; ++r) {
            ss[r] = sum32(ss[r]);
            ss[r] = __builtin_amdgcn_rsqf(ss[r] * (1.0f / DV) + EPS) * outscale;
        }
#pragma unroll
        for (int d = 0; d < NDB; ++d) {
            const float g = gsub[d * 32 + r32];
#pragma unroll
            for (int r = 0; r < 16; ++r) {
                const float v = o[0][d][r] * ss[r] * g;
                stg[crow(r, hi) * NOUT + d * 32 + r32] = (bf16_t)(cvt_pk_bf16(v, 0.f) & 0xffffu);
            }
        }
    }
    asm volatile("s_waitcnt lgkmcnt(0)" ::: "memory");
    {
        constexpr int CPR = NOUT / 8;
        constexpr int NIT = 32 * CPR / 64;
#pragma unroll
        for (int i = 0; i < NIT; ++i) {
            const int idx = i * 64 + lane; const int row = idx / CPR, ch = idx % CPR;
            const u32x4 v = *(const LAS u32x4*)(stg + row * NOUT + ch * 8);
            *(u32x4*)(Y + (size_t)(qrow0 + wid * 32 + row) * DM + ch * 8) = v;
        }
    }
}

__device__ __forceinline__ void bmix_unit(LAS unsigned char* lds, const bf16_t* U, const bf16_t* VG, const float* gv  , const float* ws  , const float* bs  ,
                                          int ci, int g, bf16_t* Y) {
    const int tid = opaque_tid(), lane = tid & 63, r32 = lane & 31, hi = lane >> 5; const int wid = __builtin_amdgcn_readfirstlane(tid >> 6);
    const int r0 = ci * 128;
    LAS float* rstd = (LAS float*)lds;
    LAS bf16_t* vnT = (LAS bf16_t*)(lds + 512);
    {
        const int q = tid >> 2, part = tid & 3; float ss = 0.f;
        const bf16_t* p = VG + (size_t)(r0 + q) * 256 + part * 64;
#pragma unroll
        for (int i = 0; i < 8; ++i) { const u32x4 w = *(const u32x4*)(p + 8 * i);
#pragma unroll
            for (int e = 0; e < 4; ++e) { const float lo = __uint_as_float(w[e] << 16), hi2 = __uint_as_float(w[e] & 0xffff0000u); ss += lo * lo + hi2 * hi2; } }
        ss += swz_xor<1>(ss); ss += swz_xor<2>(ss);
        if (part == 0) rstd[q] = __builtin_amdgcn_rsqf(ss * (1.0f / 256.0f) + EPS);
    }
    __syncthreads();
#pragma unroll
    for (int i = 0; i < 2; ++i) {
        const int idx = tid + i * NTHREADS; const int q = idx >> 3, c8 = idx & 7;
        const u32x4 w = *(const u32x4*)(VG + (size_t)(r0 + q) * 256 + g * 64 + c8 * 8); const float rs = rstd[q];
#pragma unroll
        for (int e = 0; e < 4; ++e) {
            const float lo = __uint_as_float(w[e] << 16) * rs * gv[g * 64 + c8 * 8 + 2 * e], hi2 = __uint_as_float(w[e] & 0xffff0000u) * rs * gv[g * 64 + c8 * 8 + 2 * e + 1];
            const unsigned pk = cvt_pk_bf16(lo, hi2);
            vnT[(c8 * 8 + 2 * e) * 136 + q] = (bf16_t)(pk & 0xffffu); vnT[(c8 * 8 + 2 * e + 1) * 136 + q] = (bf16_t)(pk >> 16);
        }
    }
    __syncthreads();
    const int pblk = wid & 3, cblk = wid >> 2;
    f32x16 acc;
#pragma unroll
    for (int r = 0; r < 16; ++r) acc[r] = 0.f;
    const float* wrow = ws + ((size_t)g * 128 + pblk * 32 + r32) * 128 + hi * 8;
#pragma unroll
    for (int ks = 0; ks < 8; ++ks) {
        const f32x4 a0 = *(const f32x4*)(wrow + ks * 16), a1 = *(const f32x4*)(wrow + ks * 16 + 4);
        u32x4 aw; aw.x = cvt_pk_bf16(a0[0], a0[1]); aw.y = cvt_pk_bf16(a0[2], a0[3]); aw.z = cvt_pk_bf16(a1[0], a1[1]); aw.w = cvt_pk_bf16(a1[2], a1[3]);
        const bf16x8 bfr = *(const LAS bf16x8*)(vnT + (cblk * 32 + r32) * 136 + ks * 16 + hi * 8);
        acc = __builtin_amdgcn_mfma_f32_32x32x16_bf16(__builtin_bit_cast(bf16x8, aw), bfr, acc, 0, 0, 0);
    }
#pragma unroll
    for (int r = 0; r < 16; ++r) {
        const int p = pblk * 32 + crow(r, hi); const int col = g * 64 + cblk * 32 + r32;
        const float mixed = acc[r] + bs[g * 128 + p];
        const float uu = bf2f(U[(size_t)(r0 + p) * 256 + col]);
        Y[(size_t)(r0 + p) * DM + 384 + col] = (bf16_t)(cvt_pk_bf16(uu * mixed, 0.f) & 0xffffu);
    }
    __syncthreads();
}

__device__ __forceinline__ void mixer_phase(const Args& a, LAS unsigned char* lds, int l, unsigned* ctr) {
    const bool last = (l == DEPTH - 1);
    unsigned char* mx = a.ws + WS_ACT;
    bf16_t* Y = (bf16_t*)(a.ws + WS_H);
    const bf16_t* QA = (const bf16_t*)(mx + MX_QA); const bf16_t* KA = (const bf16_t*)(mx + MX_KA);
    const bf16_t* QC = (const bf16_t*)(mx + MX_QC); const bf16_t* KC = (const bf16_t*)(mx + MX_KC);
    const bf16_t* VT = (const bf16_t*)(mx + MX_VT);
    const int nC = 512, nA = 512, nCc = last ? 0 : 16, nAc = last ? 0 : 16, nB = last ? 1024 : 1056;
    const int total = nC + nA + nCc + nAc + nB;
    const float* lv = a.in[I_LAM] + l * 4 * 48;
    float d1 = 0.f, d2 = 0.f;
    for (int i = 0; i < 48; ++i) { d1 += lv[i] * lv[48 + i]; d2 += lv[96 + i] * lv[144 + i]; }
    const float lam_init = 0.8f - 0.6f * expf(-0.3f * (float)l);
    const float lam = expf(d1) - expf(d2) + lam_init;
    LAS unsigned* sidx = (LAS unsigned*)(lds + LDS_MISC + 64);
    for (;;) {
        if (opaque_tid() == 0) *sidx = atomicAdd(ctr, 1u);
        __syncthreads();
        const int idx = (int)*sidx;
        __syncthreads();
        if (idx >= total) break;
        int j = idx;
        if (j < nC) {
            const int b = j >> 7, h = (j >> 5) & 3, qb = j & 31;
            attn_unit<2, 48, 96, false>(lds, QC + (size_t)h * R * 48, KC + (size_t)h * R * 48, 4 * R * 48, VT + (size_t)(128 + h * 96) * R, b * SEQ + qb * 256, b, 0, 132, Y + 640 + h * 96, lam, a.in[I_GSUB] + l * 96, 1.0f - lam_init);
            continue;
        }
        j -= nC;
        if (j < nA) {
            const int pair = j < 256; const int jj = j & 255; const int b = jj >> 6, hkv = (jj >> 5) & 1, qb = jj & 31;
            if (pair) attn_unit<2, 64, 64, true>(lds, QA + (size_t)(hkv * 3) * R * 64, KA + (size_t)hkv * R * 64, R * 64, VT + (size_t)(hkv * 64) * R, b * SEQ + qb * 256, b, 0, 132, Y + hkv * 192, 0.f, nullptr, 1.0f);
            else attn_unit<1, 64, 64, true>(lds, QA + (size_t)(hkv * 3 + 2) * R * 64, KA + (size_t)hkv * R * 64, 0, VT + (size_t)(hkv * 64) * R, b * SEQ + qb * 256, b, 0, 132, Y + hkv * 192 + 128, 0.f, nullptr, 1.0f);
            continue;
        }
        j -= nA;
        if (j < nCc) {
            const int b = j >> 2, h = j & 3;
            attn_unit<2, 48, 96, false>(lds, QC + (size_t)h * R * 48, KC + (size_t)h * R * 48, 4 * R * 48, VT + (size_t)(128 + h * 96) * R, RL + b * CTXL, b, 128, 132, Y + 640 + h * 96, lam, a.in[I_GSUB] + l * 96, 1.0f - lam_init);
            continue;
        }
        j -= nCc;
        if (j < nAc) {
            const int pair = j < 8; const int jj = j & 7; const int b = jj >> 1, hkv = jj & 1;
            if (pair) attn_unit<2, 64, 64, true>(lds, QA + (size_t)(hkv * 3) * R * 64, KA + (size_t)hkv * R * 64, R * 64, VT + (size_t)(hkv * 64) * R, RL + b * CTXL, b, 128, 132, Y + hkv * 192, 0.f, nullptr, 1.0f);
            else attn_unit<1, 64, 64, true>(lds, QA + (size_t)(hkv * 3 + 2) * R * 64, KA + (size_t)hkv * R * 64, 0, VT + (size_t)(hkv * 64) * R, RL + b * CTXL, b, 128, 132, Y + hkv * 192 + 128, 0.f, nullptr, 1.0f);
            continue;
        }
        j -= nAc;
        bmix_unit(lds, (const bf16_t*)(mx + MX_U), (const bf16_t*)(mx + MX_VG), a.in[I_GV] + l * 256, a.in[I_WS] + (size_t)l * 4 * 128 * 128, a.in[I_BS] + l * 4 * 128, j >> 2, j & 3, Y);
    }
}

__global__ void __launch_bounds__(NTHREADS, 2) fwd_megakernel(Args a) {
    extern __shared__ __attribute__((aligned(16))) unsigned char lds_raw[];
    LAS unsigned char* lds = (LAS unsigned char*)lds_raw;
    const int tid = threadIdx.x, lane = tid & 63; const int wave = __builtin_amdgcn_readfirstlane(tid >> 6);
    const int G = gridDim.x, bx = blockIdx.x;
    volatile LAS unsigned* MISC = (volatile LAS unsigned*)(lds + LDS_MISC);
    if (tid < 64) MISC[tid] = 0u;
    __syncthreads();
    unsigned* ctl = (unsigned*)(a.ws + WS_CTL);
    XcdBarrier bar = xcd_barrier_post(ctl + 4096, MISC + 8);
    unsigned* qctr = ctl + 16384;

    phase0(a, lds, tid, lane, wave);
    cg::this_grid().sync();

    float* xres = (float*)(a.ws + WS_XRES);
    bf16_t* H = (bf16_t*)(a.ws + WS_H);
    bf16_t* ACT = (bf16_t*)(a.ws + WS_ACT);
    const float* modv = (const float*)(a.ws + WS_MODV);
    float* part = (float*)(a.ws + WS_PART);
#pragma unroll 1
    for (int l = 0; l < DEPTH; ++l) {
        const bool last = (l == DEPTH - 1);
        const float* modl = modv + (size_t)l * 5 * 9216;
        unsigned char* wl = a.ws + WS_W + (size_t)l * LAYER_W_BYTES;
        const float* xL = (l == 0) ? a.in[I_X] : xres;
        const float* xC = (l == 0) ? a.in[I_CTX] : xres + (size_t)RL * DM;
        norm_phase(xL, xC, a.in[I_GFFN1] + l * DM, modl, 0, H, R, part, l == 0 ? 0 : 11, modl - 5 * 9216 + 4 * 9216 + 8 * 1024, 0.5f, xres + (size_t)RL * DM);
        xcd_barrier(bar);
        { pg8::SchedOne S{(const char*)H, (const char*)(wl + W_1IN), 132, 22, G, bx, (size_t)256 * 1024 * 2, 16}; pg8::EpiUp E{ACT};
          pg8::gemm_phase<pg8::EpiUp, pg8::SchedOne>(lds, 1024, S, E); }
        xcd_barrier(bar);
        { pg8::SchedDown S{(const char*)ACT, (const char*)(wl + W_1OUT), G, bx, (size_t)256 * FF * 2, 44, 4, 11, 4}; pg8::EpiDown E{xL, xres + (size_t)RL * DM, xres, modl + 2 * 1024, 0.5f, part};
          pg8::gemm_phase<pg8::EpiDown, pg8::SchedDown>(lds, FF, S, E); }
        xcd_barrier(bar);
        norm_phase(xres, xres + (size_t)RL * DM, a.in[I_GMIX] + l * DM, modl, 3, H, R, part, 11, modl + 4 * 9216 + 2 * 1024, 0.5f, xres + (size_t)RL * DM);
        xcd_barrier(bar);
        { pg8::SchedMix S{(const char*)H, (const char*)(wl + W_MIX), (const char*)(wl + W_MIX) + (size_t)1792 * 1024 * 2, G, bx, (size_t)256 * 1024 * 2};
          pg8::EpiMix E{a.ws + WS_ACT, (const float*)(a.ws + WS_GTAB) + l * 128, (const float*)(a.ws + WS_GTAB) + l * 128 + 64};
          pg8::gemm_phase<pg8::EpiMix, pg8::SchedMix>(lds, 1024, S, E); }
        xcd_barrier(bar);
        mixer_phase(a, lds, l, qctr + 64 * l);
        xcd_barrier(bar);
        { pg8::SchedDown S{(const char*)H, (const char*)(wl + W_OUT), G, bx, (size_t)256 * 1024 * 2, 16, last ? 0 : 4, 4, 4}; pg8::EpiDown E{xres, xres + (size_t)RL * DM, xres, modl + 5 * 1024, 1.0f, part};
          pg8::gemm_phase<pg8::EpiDown, pg8::SchedDown>(lds, 1024, S, E); }
        xcd_barrier(bar);
        norm_phase(xres, xres + (size_t)RL * DM, a.in[I_GFFN2] + l * DM, modl, 6, H, last ? RL : R, part, 4, modl + 4 * 9216 + 5 * 1024, 1.0f, xres + (size_t)RL * DM);
        xcd_barrier(bar);
        { pg8::SchedOne S{(const char*)H, (const char*)(wl + W_2IN), last ? 128 : 132, 22, G, bx, (size_t)256 * 1024 * 2, 16}; pg8::EpiUp E{ACT};
          pg8::gemm_phase<pg8::EpiUp, pg8::SchedOne>(lds, 1024, S, E); }
        xcd_barrier(bar);
        { pg8::SchedDown S{(const char*)ACT, (const char*)(wl + W_2OUT), G, bx, (size_t)256 * FF * 2, 44, last ? 0 : 4, 11, 4}; pg8::EpiDown E{xres, xres + (size_t)RL * DM, xres, modl + 8 * 1024, 0.5f, part};
          pg8::gemm_phase<pg8::EpiDown, pg8::SchedDown>(lds, FF, S, E); }
        xcd_barrier(bar);
    }
    final_phase(xres, a.in[I_GFINAL], a.out);
}

extern "C" void kernel_launch(void* const* d_in, const int* in_sizes, int n_in, void* d_out, int out_size, void* d_ws, size_t ws_size, hipStream_t stream) {
    static int grid = 0;
    if (grid == 0) {
        if (n_in != 23 || ws_size < WS_END) { fprintf(stderr, "kernel_launch: n_in %d ws %zu (need %zu)\n", n_in, ws_size, (size_t)WS_END); grid = -1; return; }
        int dev = 0, cus = 0, per_cu = 0;
        hipGetDevice(&dev); hipDeviceGetAttribute(&cus, hipDeviceAttributeMultiprocessorCount, dev);
        hipFuncSetAttribute((const void*)fwd_megakernel, hipFuncAttributeMaxDynamicSharedMemorySize, LDS_BYTES);
        hipOccupancyMaxActiveBlocksPerMultiprocessor(&per_cu, (const void*)fwd_megakernel, NTHREADS, LDS_BYTES);
        (void)hipGetLastError();
        if (per_cu < 1) { fprintf(stderr, "kernel_launch: occupancy query says %d blocks per CU\n", per_cu); per_cu = 1; }
        grid = cus;
    }
    if (grid < 0) return;
    hipMemsetAsync((char*)d_ws + WS_CTL, 0, 1 * MiB, stream);
    Args a{};
    for (int i = 0; i < 23; ++i) a.in[i] = (const float*)d_in[i];
    a.out = (float*)d_out; a.ws = (unsigned char*)d_ws;
    void* args[] = {&a};
    hipError_t e = hipLaunchCooperativeKernel((const void*)fwd_megakernel, dim3(grid), dim3(NTHREADS), args, LDS_BYTES, stream);
    if (e != hipSuccess) fprintf(stderr, "cooperative launch failed: %s (grid %d)\n", hipGetErrorString(e), grid);
}
```
